# Optimizing an MI355X kernel written in HIP

```python
import math
import jax, jax.numpy as jnp
from jax import lax
import numpy as np

D_MODEL = 2048
BATCH = 4
SEQ = 2048
DEPTH = 4

CHUNK = 64
Q_BLOCK = 128
ROPE_THETA = 10000.0
EPS = 1e-6
NEG = -1e30
D_MIX = D_MODEL
D_FF = 4 * D_MODEL

A_HEADS = 4
A_DQK = D_MIX // 16
A_DV = 2 * A_DQK
A_WIDTH = A_HEADS * A_DV

B_GROUPS = 4
B_CH = D_MIX // 16
B_WIDTH = B_GROUPS * B_CH
B_BLOCK = 128

C_HEADS = 4
C_DH = D_MIX // 16
C_WIDTH = C_HEADS * C_DH
IDX_HEADS = 8
IDX_DH = D_MIX // 32
TOPK_MAX = 256

IN_SIZES = (
    A_HEADS * 2 * A_DQK,
    A_HEADS * 2 * A_DQK,
    A_HEADS * A_DV,
    B_WIDTH,
    B_WIDTH,
    C_WIDTH,
    C_WIDTH,
    C_WIDTH,
    IDX_HEADS * IDX_DH,
    IDX_DH,
    IDX_HEADS,
)
N_IN = sum(IN_SIZES)

kernel_name = "hybrid_diffattn_gmlp_dsa_trunk"


def rms_norm(x, gain=None):
    xf = x.astype(jnp.float32)
    y = xf * lax.rsqrt(jnp.mean(xf * xf, axis=-1, keepdims=True) + EPS)
    if gain is not None:
        y = y * gain.astype(jnp.float32)
    return y.astype(x.dtype)


def rope_tables(seq, dim, dtype):
    inv = 1.0 / (ROPE_THETA ** (jnp.arange(0, dim, 2, dtype=jnp.float32) / dim))
    ang = jnp.arange(seq, dtype=jnp.float32)[:, None] * inv[None, :]
    ang = jnp.concatenate([ang, ang], axis=-1)
    return jnp.cos(ang).astype(dtype), jnp.sin(ang).astype(dtype)


def apply_rope(x, cos, sin):
    shape = (x.shape[1],) + (1,) * (x.ndim - 3) + (x.shape[-1],)
    half = x.shape[-1] // 2
    rot = jnp.concatenate([-x[..., half:], x[..., :half]], axis=-1)
    return x * cos.reshape(shape) + rot * sin.reshape(shape)


def to_blocks(t):
    b, s = t.shape[:2]
    return jnp.moveaxis(t.reshape((b, s // Q_BLOCK, Q_BLOCK) + t.shape[2:]), 1, 0)


def from_blocks(t):
    t = jnp.moveaxis(t, 0, 1)
    return t.reshape((t.shape[0], t.shape[1] * t.shape[2]) + t.shape[3:])


def diff_attention(q, k, v, lam, lambda_init, subln_gain):
    S = q.shape[1]
    scale = q.shape[-1] ** -0.5
    key_chunk = jnp.arange(S) // CHUNK
    starts = jnp.arange(S // Q_BLOCK) * Q_BLOCK

    def one_block(args):
        qb, start = args
        s = jnp.einsum('bqhmd,bshmd->bmhqs', qb, k).astype(jnp.float32) * scale
        q_chunk = (start + jnp.arange(Q_BLOCK)) // CHUNK
        mask = key_chunk[None, :] <= q_chunk[:, None]
        p = jax.nn.softmax(jnp.where(mask, s, NEG), axis=-1)
        a = p[:, 0] - lam * p[:, 1]
        return jnp.einsum('bhqs,bshe->bqhe', a.astype(v.dtype), v)

    o = from_blocks(lax.map(one_block, (to_blocks(q), starts)))
    return rms_norm(o, subln_gain) * (1.0 - lambda_init)


def spatial_gating(u, v, v_gain, ws, bias):
    b, S = u.shape[:2]
    v = rms_norm(v.reshape(b, S, B_GROUPS, B_CH), v_gain.reshape(B_GROUPS, B_CH))
    v = v.reshape(b, S // B_BLOCK, B_BLOCK, B_GROUPS, B_CH)
    pos_chunk = jnp.arange(B_BLOCK) // CHUNK
    mask = pos_chunk[None, :] <= pos_chunk[:, None]
    w = jnp.where(mask[None], ws, 0.0).astype(v.dtype)
    z = jnp.einsum('gij,bnjgc->bnigc', w, v) + bias.T[None, None, :, :, None]
    return u * z.reshape(b, S, B_WIDTH)


def dsa_attention(q, k, v, qi, ki, wi, topk):
    b, S = q.shape[:2]
    scale = q.shape[-1] ** -0.5
    key_chunk = jnp.arange(S) // CHUNK
    starts = jnp.arange(S // Q_BLOCK) * Q_BLOCK
    bidx = jnp.arange(b)[:, None, None]

    def one_block(args):
        qb, qib, wib, start = args
        q_chunk = (start + jnp.arange(Q_BLOCK)) // CHUNK
        mask = key_chunk[None, :] <= q_chunk[:, None]
        iscore = jnp.einsum('bqhd,bsd->bqhs', qib, ki).astype(jnp.float32)
        iscore = jnp.einsum('bqhs,bqh->bqs', jax.nn.relu(iscore), wib.astype(jnp.float32))
        iscore = jnp.where(mask[None], iscore, NEG)
        top_val, top_idx = lax.top_k(iscore, topk)
        valid = top_val > 0.5 * NEG
        kg = k[bidx, top_idx]
        vg = v[bidx, top_idx]
        s = jnp.einsum('bqhd,bqkhd->bhqk', qb, kg).astype(jnp.float32) * scale
        p = jax.nn.softmax(jnp.where(valid[:, None], s, NEG), axis=-1)
        return jnp.einsum('bhqk,bqkhd->bqhd', p.astype(vg.dtype), vg)

    return from_blocks(lax.map(one_block, (to_blocks(q), to_blocks(qi), to_blocks(wi), starts)))


def setup_inputs(seed: int = 0) -> dict:
    key = jax.random.key(seed)
    ks = jax.random.split(key, 17)

    def nrm(k, shape, s):
        return jax.random.normal(k, shape, jnp.float32) * s

    L = DEPTH
    return {
        "x": nrm(ks[0], (BATCH, SEQ, D_MODEL), 1.0),
        "c": nrm(ks[1], (BATCH, D_MODEL), 1.0),
        "w_mod": nrm(ks[2], (L, D_MODEL, 6 * D_MODEL), 0.5 * D_MODEL ** -0.5),
        "b_mod": nrm(ks[3], (L, 6 * D_MODEL), 0.01),
        "w_in": nrm(ks[4], (L, D_MODEL, N_IN), D_MODEL ** -0.5),
        "w_out": nrm(ks[5], (L, D_MIX, D_MODEL), D_MIX ** -0.5),
        "a_qnorm": 1.0 + nrm(ks[6], (L, A_DQK), 0.05),
        "a_knorm": 1.0 + nrm(ks[7], (L, A_DQK), 0.05),
        "a_lambda": nrm(ks[8], (L, 4, A_DQK), 0.1),
        "a_subln": 1.0 + nrm(ks[9], (L, A_DV), 0.05),
        "b_vnorm": 1.0 + nrm(ks[10], (L, B_WIDTH), 0.05),
        "b_ws": nrm(ks[11], (L, B_GROUPS, B_BLOCK, B_BLOCK), B_BLOCK ** -0.5),
        "b_bias": 1.0 + nrm(ks[12], (L, B_GROUPS, B_BLOCK), 0.1),
        "c_qnorm": 1.0 + nrm(ks[13], (L, C_DH), 0.05),
        "c_knorm": 1.0 + nrm(ks[14], (L, C_DH), 0.05),
        "w_ff1": nrm(ks[15], (L, D_MODEL, D_FF), D_MODEL ** -0.5),
        "w_ff2": nrm(ks[16], (L, D_FF, D_MODEL), D_FF ** -0.5),
    }


def reference(x, c, w_mod, b_mod, w_in, w_out, a_qnorm, a_knorm, a_lambda, a_subln,
              b_vnorm, b_ws, b_bias, c_qnorm, c_knorm, w_ff1, w_ff2):
    B, S, _ = x.shape
    topk = min(TOPK_MAX, S // 4)
    cos128, sin128 = rope_tables(S, A_DQK, x.dtype)
    cos64, sin64 = rope_tables(S, IDX_DH, x.dtype)
    offs = []
    acc = 0
    for n in IN_SIZES[:-1]:
        acc += n
        offs.append(acc)
    c_act = jax.nn.silu(c)

    for l in range(DEPTH):
        lambda_init = 0.8 - 0.6 * math.exp(-0.3 * l)
        mod = jnp.einsum('bd,de->be', c_act, w_mod[l]) + b_mod[l]
        sh1, sc1, g1, sh2, sc2, g2 = jnp.split(mod[:, None, :], 6, axis=-1)

        h = rms_norm(x) * (1.0 + sc1) + sh1
        proj = jnp.einsum('bsd,de->bse', h, w_in[l])
        aq, ak, av, bu, bv, cq, ck, cv, iq, ik, iw = jnp.split(proj, offs, axis=-1)

        aq = apply_rope(rms_norm(aq.reshape(B, S, A_HEADS, 2, A_DQK), a_qnorm[l]), cos128, sin128)
        ak = apply_rope(rms_norm(ak.reshape(B, S, A_HEADS, 2, A_DQK), a_knorm[l]), cos128, sin128)
        lam_p = a_lambda[l].astype(jnp.float32)
        lam = (jnp.exp(jnp.sum(lam_p[0] * lam_p[1])) - jnp.exp(jnp.sum(lam_p[2] * lam_p[3]))
               + lambda_init)
        oa = diff_attention(aq, ak, av.reshape(B, S, A_HEADS, A_DV), lam, lambda_init, a_subln[l])

        ob = spatial_gating(jax.nn.gelu(bu), jax.nn.gelu(bv), b_vnorm[l], b_ws[l], b_bias[l])

        cq = apply_rope(rms_norm(cq.reshape(B, S, C_HEADS, C_DH), c_qnorm[l]), cos128, sin128)
        ck = apply_rope(rms_norm(ck.reshape(B, S, C_HEADS, C_DH), c_knorm[l]), cos128, sin128)
        iq = apply_rope(iq.reshape(B, S, IDX_HEADS, IDX_DH), cos64, sin64)
        ik = apply_rope(ik, cos64, sin64)
        iw = iw * (IDX_HEADS ** -0.5 * IDX_DH ** -0.5)
        oc = dsa_attention(cq, ck, cv.reshape(B, S, C_HEADS, C_DH), iq, ik, iw, topk)

        mix = jnp.concatenate([oa.reshape(B, S, A_WIDTH), ob, oc.reshape(B, S, C_WIDTH)], axis=-1)
        x = x + g1 * jnp.einsum('bse,ed->bsd', mix, w_out[l])

        h = rms_norm(x) * (1.0 + sc2) + sh2
        ff = jnp.square(jax.nn.relu(jnp.einsum('bsd,df->bsf', h, w_ff1[l])))
        x = x + g2 * jnp.einsum('bsf,fd->bsd', ff, w_ff2[l])

    return x
```

```cpp
#include <hip/hip_runtime.h>
#include <cstdio>
#include <cstdint>
#include <cmath>

constexpr int DM = 2048, BATCH = 4, SEQ = 2048, DEPTH = 4, M = BATCH * SEQ, DFF = 4 * DM;
constexpr int CHUNK = 64, TOPK = 256;
constexpr int NIN = 6216, NINP = 6400;
constexpr int OFF_AQ = 0, OFF_AK = 1024, OFF_AV = 2048, OFF_BU = 3072, OFF_BV = 3584, OFF_CQ = 4096, OFF_CK = 4608, OFF_CV = 5120, OFF_IQ = 5632, OFF_IK = 6144, OFF_IW = 6208;
constexpr float EPS = 1e-6f, ROPE_THETA = 10000.0f;
constexpr float QSCALE = 0.08838834764831845f * 1.4426950408889634f;
constexpr float IWSCALE = 0.35355339059327373f * 0.125f;
enum { I_X = 0, I_C, I_WMOD, I_BMOD, I_WIN, I_WOUT, I_AQN, I_AKN, I_ALAM, I_ASUB, I_BVN, I_BWS, I_BBIAS, I_CQN, I_CKN, I_WFF1, I_WFF2 };

constexpr size_t MiB = 1u << 20;
constexpr size_t WS_CTL = 0, CTL_ZERO_BYTES = 1 * MiB;
constexpr size_t WS_MOD = 1 * MiB;
constexpr size_t WS_WIN = 2 * MiB;
constexpr size_t WS_WOUT = WS_WIN + 100 * MiB;
constexpr size_t WS_WFF1 = WS_WOUT + 32 * MiB;
constexpr size_t WS_WFF2 = WS_WFF1 + 128 * MiB;
constexpr size_t WS_XN = WS_WFF2 + 128 * MiB;
constexpr size_t WS_AQ = WS_XN + 32 * MiB, WS_AK = WS_AQ + 16 * MiB, WS_AV = WS_AK + 16 * MiB;
constexpr size_t WS_BU = WS_AV + 16 * MiB, WS_BV = WS_BU + 8 * MiB, WS_CQ = WS_BV + 8 * MiB, WS_CK = WS_CQ + 8 * MiB, WS_CV = WS_CK + 8 * MiB, WS_IQ = WS_CV + 8 * MiB;
constexpr size_t WS_IK = WS_IQ + 8 * MiB;
constexpr size_t WS_IW = WS_IK + 1 * MiB;
constexpr size_t WS_SEL = WS_IW + 1 * MiB;
constexpr size_t WS_MIX = WS_SEL + 2 * MiB;
constexpr size_t WS_OA = WS_MIX + 32 * MiB;
constexpr size_t WS_FF = WS_OA + 64 * MiB;
constexpr size_t WS_ROPE = WS_FF + 128 * MiB;
constexpr size_t WS_PROJ = WS_ROPE + 2 * MiB;
constexpr size_t WS_WINN = WS_PROJ + 200 * MiB;
constexpr size_t WS_END = WS_WINN + 25 * MiB;
namespace nv {
typedef unsigned short bf16_t;
typedef short bf16x8 __attribute__((ext_vector_type(8)));
typedef float f32x4 __attribute__((ext_vector_type(4)));

__device__ __forceinline__ float bf2f(bf16_t v) { return __uint_as_float(((unsigned)v) << 16); }
__device__ __forceinline__ bf16_t f2bf(float f) { unsigned u = __float_as_uint(f); return (bf16_t)((u + 0x7fffu + ((u >> 16) & 1u)) >> 16); }
__device__ __forceinline__ float gelu_tanh(float x) { const float u = 0.7978845608028654f * (x + 0.044715f * x * x * x); return 0.5f * x * (1.f + tanhf(u)); }

__device__ __forceinline__ float block_sum(float v, float* red) {
    for (int o = 32; o > 0; o >>= 1) v += __shfl_xor(v, o);
    __syncthreads();
    if ((threadIdx.x & 63) == 0) red[threadIdx.x >> 6] = v;
    __syncthreads();
    return red[0] + red[1] + red[2] + red[3];
}
__device__ __forceinline__ float block_max(float v, float* red) {
    for (int o = 32; o > 0; o >>= 1) v = fmaxf(v, __shfl_xor(v, o));
    __syncthreads();
    if ((threadIdx.x & 63) == 0) red[threadIdx.x >> 6] = v;
    __syncthreads();
    return fmaxf(fmaxf(red[0], red[1]), fmaxf(red[2], red[3]));
}

__global__ void k_transpose(const float* __restrict__ W, bf16_t* __restrict__ Wt, int K, int N, int Npad) {
    __shared__ float t[32][33];
    const int n0 = blockIdx.x * 32, k0 = blockIdx.y * 32;
    for (int i = threadIdx.y; i < 32; i += 8) { const int n = n0 + threadIdx.x; t[i][threadIdx.x] = (n < N) ? W[(size_t)(k0 + i) * N + n] : 0.f; }
    __syncthreads();
    for (int i = threadIdx.y; i < 32; i += 8) Wt[(size_t)(n0 + i) * K + k0 + threadIdx.x] = f2bf(t[threadIdx.x][i]);
}

__global__ void k_mod(const float* __restrict__ c, const float* __restrict__ w_mod, const float* __restrict__ b_mod, float* __restrict__ mod) {
    const int e = blockIdx.x * 256 + threadIdx.x, l = blockIdx.y;
    __shared__ float ca[BATCH][DM];
    for (int i = threadIdx.x; i < BATCH * DM; i += 256) { const float v = c[i]; ca[i / DM][i % DM] = v / (1.f + expf(-v)); }
    __syncthreads();
    float a0 = 0, a1 = 0, a2 = 0, a3 = 0;
    const float* w = w_mod + (size_t)l * DM * 6 * DM + e;
    for (int d = 0; d < DM; ++d) { const float wv = w[(size_t)d * 6 * DM]; a0 += ca[0][d] * wv; a1 += ca[1][d] * wv; a2 += ca[2][d] * wv; a3 += ca[3][d] * wv; }
    const float bb = b_mod[(size_t)l * 6 * DM + e];
    float* o = mod + (size_t)l * BATCH * 6 * DM + e;
    o[0] = a0 + bb; o[6 * DM] = a1 + bb; o[2 * 6 * DM] = a2 + bb; o[3 * 6 * DM] = a3 + bb;
}

__global__ void k_norm_mod(const float* __restrict__ X, const float* __restrict__ modl, int shi, int sci, bf16_t* __restrict__ XN) {
    __shared__ float red[4];
    const int m = blockIdx.x, b = m / SEQ;
    const float* x = X + (size_t)m * DM; float v[8]; float s = 0.f;
    for (int i = 0; i < 8; ++i) { v[i] = x[threadIdx.x + 256 * i]; s += v[i] * v[i]; }
    s = block_sum(s, red);
    const float r = rsqrtf(s * (1.f / DM) + EPS);
    const float* mb = modl + (size_t)b * 6 * DM;
    for (int i = 0; i < 8; ++i) { const int d = threadIdx.x + 256 * i; XN[(size_t)m * DM + d] = f2bf(v[i] * r * (1.f + mb[sci * DM + d]) + mb[shi * DM + d]); }
}

template <int MODE>
__global__ void __launch_bounds__(256) k_gemm(const bf16_t* __restrict__ A, const bf16_t* __restrict__ Bt, int K, int N, float* Cf, int ldc, const float* __restrict__ gate, bf16_t* Ob) {
    const int wid = threadIdx.x >> 6, lane = threadIdx.x & 63, fr = lane & 15, fq = lane >> 4;
    const int m0 = blockIdx.y * 128 + (wid >> 1) * 64, n0 = blockIdx.x * 128 + (wid & 1) * 64;
    f32x4 acc[4][4];
    for (int i = 0; i < 4; ++i) for (int j = 0; j < 4; ++j) acc[i][j] = (f32x4){0.f, 0.f, 0.f, 0.f};
    const bf16_t* ap = A + (size_t)(m0 + fr) * K + fq * 8; const bf16_t* bp = Bt + (size_t)(n0 + fr) * K + fq * 8;
    for (int k0 = 0; k0 < K; k0 += 32) {
        bf16x8 a[4], b[4];
#pragma unroll
        for (int i = 0; i < 4; ++i) { a[i] = *(const bf16x8*)(ap + (size_t)(16 * i) * K + k0); b[i] = *(const bf16x8*)(bp + (size_t)(16 * i) * K + k0); }
#pragma unroll
        for (int i = 0; i < 4; ++i)
#pragma unroll
            for (int j = 0; j < 4; ++j) acc[i][j] = __builtin_amdgcn_mfma_f32_16x16x32_bf16(b[j], a[i], acc[i][j], 0, 0, 0);
    }
#pragma unroll
    for (int i = 0; i < 4; ++i)
#pragma unroll
        for (int j = 0; j < 4; ++j)
#pragma unroll
            for (int e = 0; e < 4; ++e) {
                const int m = m0 + 16 * i + fr, n = n0 + 16 * j + 4 * fq + e; const float v = acc[i][j][e];
                if (n < N) {
                    if (MODE == 0) Cf[(size_t)m * ldc + n] = v;
                    else if (MODE == 1) { const int b = m / SEQ; Cf[(size_t)m * ldc + n] += gate[(size_t)b * 6 * DM + n] * v; }
                    else { const float r = fmaxf(v, 0.f); Ob[(size_t)m * ldc + n] = f2bf(r * r); }
                }
            }
}

struct PostArgs { const float* proj; const float* a_qnorm; const float* a_knorm; const float* b_vnorm; const float* c_qnorm; const float* c_knorm;
                  bf16_t *AQ, *AK, *AV, *BU, *BV, *CQ, *CK, *CV, *IQ, *IK; float* IW; };
__device__ __forceinline__ void rope_angle(int pos, int i, int dim, float& cs, float& sn) {
    const float inv = 1.0f / powf(ROPE_THETA, (float)(2 * i) / (float)dim); const float ang = (float)pos * inv; cs = cosf(ang); sn = sinf(ang);
}
__global__ void __launch_bounds__(256) k_post_in(PostArgs p) {
    const int m = blockIdx.x, pos = m % SEQ, wid = threadIdx.x >> 6, lane = threadIdx.x & 63;
    const float* row = p.proj + (size_t)m * NINP;
    for (int v = wid; v < 24; v += 4) {
        const float* src; const float* gain; bf16_t* dst; float qs = 1.f;
        if (v < 8) { src = row + OFF_AQ + v * 128; gain = p.a_qnorm; dst = p.AQ + (size_t)m * 1024 + v * 128; qs = QSCALE; }
        else if (v < 16) { src = row + OFF_AK + (v - 8) * 128; gain = p.a_knorm; dst = p.AK + (size_t)m * 1024 + (v - 8) * 128; }
        else if (v < 20) { src = row + OFF_CQ + (v - 16) * 128; gain = p.c_qnorm; dst = p.CQ + (size_t)m * 512 + (v - 16) * 128; qs = QSCALE; }
        else { src = row + OFF_CK + (v - 20) * 128; gain = p.c_knorm; dst = p.CK + (size_t)m * 512 + (v - 20) * 128; }
        const float x0 = src[lane], x1 = src[lane + 64]; float s = x0 * x0 + x1 * x1;
        for (int o = 32; o > 0; o >>= 1) s += __shfl_xor(s, o);
        const float r = rsqrtf(s * (1.f / 128.f) + EPS);
        const float y0 = x0 * r * gain[lane], y1 = x1 * r * gain[lane + 64];
        float cs, sn; rope_angle(pos, lane, 128, cs, sn);
        dst[lane] = f2bf((y0 * cs - y1 * sn) * qs); dst[lane + 64] = f2bf((y1 * cs + y0 * sn) * qs);
    }
    for (int i = threadIdx.x; i < 1024; i += 256) p.AV[(size_t)m * 1024 + i] = f2bf(row[OFF_AV + i]);
    for (int i = threadIdx.x; i < 512; i += 256) { p.CV[(size_t)m * 512 + i] = f2bf(row[OFF_CV + i]); p.BU[(size_t)m * 512 + i] = f2bf(gelu_tanh(row[OFF_BU + i])); }
    { const int g = wid; const float x0 = gelu_tanh(row[OFF_BV + g * 128 + lane]), x1 = gelu_tanh(row[OFF_BV + g * 128 + lane + 64]); float s = x0 * x0 + x1 * x1;
      for (int o = 32; o > 0; o >>= 1) s += __shfl_xor(s, o);
      const float r = rsqrtf(s * (1.f / 128.f) + EPS);
      p.BV[(size_t)m * 512 + g * 128 + lane] = f2bf(x0 * r * p.b_vnorm[g * 128 + lane]); p.BV[(size_t)m * 512 + g * 128 + lane + 64] = f2bf(x1 * r * p.b_vnorm[g * 128 + lane + 64]); }
    { const int h = threadIdx.x >> 5, i = threadIdx.x & 31; float cs, sn; rope_angle(pos, i, 64, cs, sn);
      const float x0 = row[OFF_IQ + h * 64 + i], x1 = row[OFF_IQ + h * 64 + i + 32];
      p.IQ[(size_t)m * 512 + h * 64 + i] = f2bf(x0 * cs - x1 * sn); p.IQ[(size_t)m * 512 + h * 64 + i + 32] = f2bf(x1 * cs + x0 * sn);
      if (h == 0) { const float k0 = row[OFF_IK + i], k1 = row[OFF_IK + i + 32]; p.IK[(size_t)m * 64 + i] = f2bf(k0 * cs - k1 * sn); p.IK[(size_t)m * 64 + i + 32] = f2bf(k1 * cs + k0 * sn); }
      if (threadIdx.x < 8) p.IW[(size_t)m * 8 + threadIdx.x] = row[OFF_IW + threadIdx.x] * IWSCALE; }
}

__global__ void __launch_bounds__(256) k_attn_a(const bf16_t* __restrict__ AQ, const bf16_t* __restrict__ AK, const bf16_t* __restrict__ AV, const float* __restrict__ a_lambda,
                                                const float* __restrict__ a_subln, float lambda_init, bf16_t* __restrict__ MIX) {
    __shared__ float q[2][128]; __shared__ float sc[2][SEQ]; __shared__ float red[4];
    const int m = blockIdx.x, h = blockIdx.y, b = m / SEQ, pos = m % SEQ, nadm = (pos / CHUNK + 1) * CHUNK, t = threadIdx.x;
    q[t >> 7][t & 127] = bf2f(AQ[(size_t)m * 1024 + h * 256 + t]);
    float l01 = 0.f, l23 = 0.f;
    if (t < 128) { l01 = a_lambda[t] * a_lambda[128 + t]; l23 = a_lambda[256 + t] * a_lambda[384 + t]; }
    l01 = block_sum(l01, red); l23 = block_sum(l23, red);
    const float lam = expf(l01) - expf(l23) + lambda_init;
    __syncthreads();
    float mx0 = -INFINITY, mx1 = -INFINITY;
    for (int j = t; j < nadm; j += 256) {
        const bf16_t* kr = AK + (size_t)(b * SEQ + j) * 1024 + h * 256; float s0 = 0.f, s1 = 0.f;
        for (int d = 0; d < 128; ++d) { s0 += q[0][d] * bf2f(kr[d]); s1 += q[1][d] * bf2f(kr[128 + d]); }
        sc[0][j] = s0; sc[1][j] = s1; mx0 = fmaxf(mx0, s0); mx1 = fmaxf(mx1, s1);
    }
    mx0 = block_max(mx0, red); mx1 = block_max(mx1, red);
    float su0 = 0.f, su1 = 0.f;
    for (int j = t; j < nadm; j += 256) { const float p0 = exp2f(sc[0][j] - mx0), p1 = exp2f(sc[1][j] - mx1); sc[0][j] = p0; sc[1][j] = p1; su0 += p0; su1 += p1; }
    su0 = block_sum(su0, red); su1 = block_sum(su1, red);
    const float i0 = 1.f / su0, i1 = lam / su1;
    __syncthreads();
    float o = 0.f;
    for (int j = 0; j < nadm; ++j) o += (sc[0][j] * i0 - sc[1][j] * i1) * bf2f(AV[(size_t)(b * SEQ + j) * 1024 + h * 256 + t]);
    const float ss = block_sum(o * o, red);
    const float r = rsqrtf(ss * (1.f / 256.f) + EPS);
    MIX[(size_t)m * DM + h * 256 + t] = f2bf(o * r * a_subln[t] * (1.f - lambda_init));
}

__global__ void __launch_bounds__(256) k_gmlp(const bf16_t* __restrict__ BU, const bf16_t* __restrict__ BV, const float* __restrict__ ws, const float* __restrict__ bias, bf16_t* __restrict__ MIX) {
    const int blk = blockIdx.x, g = blockIdx.y, c = threadIdx.x & 127, ih = threadIdx.x >> 7;
    const size_t row0 = (size_t)blk * 128;
    for (int i = ih; i < 128; i += 2) {
        float z = 0.f; const int jmax = (i / 64 + 1) * 64;
        for (int j = 0; j < jmax; ++j) z += ws[(size_t)g * 16384 + i * 128 + j] * bf2f(BV[(row0 + j) * 512 + g * 128 + c]);
        z += bias[g * 128 + i];
        MIX[(row0 + i) * DM + 1024 + g * 128 + c] = f2bf(bf2f(BU[(row0 + i) * 512 + g * 128 + c]) * z);
    }
}

__global__ void __launch_bounds__(256) k_dsa(const bf16_t* __restrict__ CQ, const bf16_t* __restrict__ CK, const bf16_t* __restrict__ CV, const bf16_t* __restrict__ IQ,
                                             const bf16_t* __restrict__ IK, const float* __restrict__ IW, bf16_t* __restrict__ MIX, unsigned* __restrict__ SEL, int use_sel) {
    __shared__ float isc[SEQ]; __shared__ unsigned char sel[SEQ]; __shared__ float qi[512]; __shared__ float w[8]; __shared__ float q[128]; __shared__ float red[4];
    const int m = blockIdx.x, b = m / SEQ, pos = m % SEQ, nadm = (pos / CHUNK + 1) * CHUNK, t = threadIdx.x;
    if (!use_sel) {
        qi[t] = bf2f(IQ[(size_t)m * 512 + t]); qi[t + 256] = bf2f(IQ[(size_t)m * 512 + t + 256]); if (t < 8) w[t] = IW[(size_t)m * 8 + t];
        __syncthreads();
        for (int j = t; j < nadm; j += 256) {
            const bf16_t* kr = IK + (size_t)(b * SEQ + j) * 64;
            float acc = 0.f;
            for (int hh = 0; hh < 8; ++hh) { float d = 0.f; for (int e = 0; e < 64; ++e) d += qi[hh * 64 + e] * bf2f(kr[e]); acc += fmaxf(d, 0.f) * w[hh]; }
            isc[j] = acc;
        }
        __syncthreads();
        for (int j = t; j < nadm; j += 256) {
            unsigned char s = 1;
            if (nadm > TOPK) { const float v = isc[j]; int rank = 0; for (int i = 0; i < nadm; ++i) { const float o = isc[i]; rank += (o > v || (o == v && i < j)) ? 1 : 0; } s = rank < TOPK; }
            sel[j] = s;
        }
        __syncthreads();
        if (t < 64) { unsigned wd = 0; for (int i = 0; i < 32; ++i) { const int j = t * 32 + i; if (j < nadm && sel[j]) wd |= 1u << i; } SEL[(size_t)m * 64 + t] = wd; }
    } else {
        for (int j = t; j < nadm; j += 256) sel[j] = (SEL[(size_t)m * 64 + (j >> 5)] >> (j & 31)) & 1u;
    }
    __syncthreads();
    for (int h = 0; h < 4; ++h) {
        if (t < 128) q[t] = bf2f(CQ[(size_t)m * 512 + h * 128 + t]);
        __syncthreads();
        float mx = -INFINITY;
        for (int j = t; j < nadm; j += 256) {
            float s = -INFINITY;
            if (sel[j]) { const bf16_t* kr = CK + (size_t)(b * SEQ + j) * 512 + h * 128; s = 0.f; for (int d = 0; d < 128; ++d) s += q[d] * bf2f(kr[d]); }
            isc[j] = s; mx = fmaxf(mx, s);
        }
        mx = block_max(mx, red);
        float su = 0.f;
        for (int j = t; j < nadm; j += 256) { const float p = exp2f(isc[j] - mx); isc[j] = p; su += p; }
        su = block_sum(su, red);
        __syncthreads();
        float o = 0.f;
        for (int j = (t >> 7); j < nadm; j += 2) o += isc[j] * bf2f(CV[(size_t)(b * SEQ + j) * 512 + h * 128 + (t & 127)]);
        __syncthreads();
        float* osum = isc;
        if (t >= 128) osum[t - 128] = o;
        __syncthreads();
        if (t < 128) MIX[(size_t)m * DM + 1536 + h * 128 + t] = f2bf((o + osum[t]) / su);
        __syncthreads();
    }
}
}
static void naive_forward(void* const* d_in, float* X, unsigned char* ws, hipStream_t stream, int l_lo, int l_hi, bool do_setup) {
    using namespace nv;
    const float* x = (const float*)d_in[I_X];
    float* MOD = (float*)(ws + WS_MOD);
    bf16_t* XN = (bf16_t*)(ws + WS_XN); bf16_t* MIX = (bf16_t*)(ws + WS_MIX); bf16_t* FF = (bf16_t*)(ws + WS_FF);
    float* PROJ = (float*)(ws + WS_PROJ); bf16_t* WINN = (bf16_t*)(ws + WS_WINN);
    if (do_setup) {
        hipMemcpyAsync(X, x, (size_t)M * DM * 4, hipMemcpyDeviceToDevice, stream);
        k_mod<<<dim3(6 * DM / 256, DEPTH), 256, 0, stream>>>((const float*)d_in[I_C], (const float*)d_in[I_WMOD], (const float*)d_in[I_BMOD], MOD);
        for (int l = 0; l < DEPTH; ++l) {
            k_transpose<<<dim3(DM / 32, DM / 32), dim3(32, 8), 0, stream>>>((const float*)d_in[I_WOUT] + (size_t)l * DM * DM, (bf16_t*)(ws + WS_WOUT) + (size_t)l * DM * DM, DM, DM, DM);
            k_transpose<<<dim3(DFF / 32, DM / 32), dim3(32, 8), 0, stream>>>((const float*)d_in[I_WFF1] + (size_t)l * DM * DFF, (bf16_t*)(ws + WS_WFF1) + (size_t)l * DM * DFF, DM, DFF, DFF);
            k_transpose<<<dim3(DM / 32, DFF / 32), dim3(32, 8), 0, stream>>>((const float*)d_in[I_WFF2] + (size_t)l * DM * DFF, (bf16_t*)(ws + WS_WFF2) + (size_t)l * DM * DFF, DFF, DM, DM);
        }
    }
    for (int l = l_lo; l < l_hi; ++l) {
        const float lambda_init = 0.8f - 0.6f * expf(-0.3f * (float)l);
        const float* modl = MOD + (size_t)l * BATCH * 6 * DM;
        k_transpose<<<dim3(NINP / 32, DM / 32), dim3(32, 8), 0, stream>>>((const float*)d_in[I_WIN] + (size_t)l * DM * NIN, WINN, DM, NIN, NINP);
        k_norm_mod<<<M, 256, 0, stream>>>(X, modl, 0, 1, XN);
        k_gemm<0><<<dim3(NINP / 128, M / 128), 256, 0, stream>>>(XN, WINN, DM, NIN, PROJ, NINP, nullptr, nullptr);
        PostArgs pa{};
        pa.proj = PROJ; pa.a_qnorm = (const float*)d_in[I_AQN] + l * 128; pa.a_knorm = (const float*)d_in[I_AKN] + l * 128; pa.b_vnorm = (const float*)d_in[I_BVN] + l * 512;
        pa.c_qnorm = (const float*)d_in[I_CQN] + l * 128; pa.c_knorm = (const float*)d_in[I_CKN] + l * 128;
        pa.AQ = (bf16_t*)(ws + WS_AQ); pa.AK = (bf16_t*)(ws + WS_AK); pa.AV = (bf16_t*)(ws + WS_AV); pa.BU = (bf16_t*)(ws + WS_BU); pa.BV = (bf16_t*)(ws + WS_BV);
        pa.CQ = (bf16_t*)(ws + WS_CQ); pa.CK = (bf16_t*)(ws + WS_CK); pa.CV = (bf16_t*)(ws + WS_CV); pa.IQ = (bf16_t*)(ws + WS_IQ); pa.IK = (bf16_t*)(ws + WS_IK); pa.IW = (float*)(ws + WS_IW);
        k_post_in<<<M, 256, 0, stream>>>(pa);
        k_attn_a<<<dim3(M, 4), 256, 0, stream>>>(pa.AQ, pa.AK, pa.AV, (const float*)d_in[I_ALAM] + l * 512, (const float*)d_in[I_ASUB] + l * 256, lambda_init, MIX);
        k_gmlp<<<dim3(M / 128, 4), 256, 0, stream>>>(pa.BU, pa.BV, (const float*)d_in[I_BWS] + (size_t)l * 4 * 128 * 128, (const float*)d_in[I_BBIAS] + l * 512, MIX);
        k_dsa<<<M, 256, 0, stream>>>(pa.CQ, pa.CK, pa.CV, pa.IQ, pa.IK, pa.IW, MIX, (unsigned*)(ws + WS_SEL), 0);
        k_gemm<1><<<dim3(DM / 128, M / 128), 256, 0, stream>>>(MIX, (bf16_t*)(ws + WS_WOUT) + (size_t)l * DM * DM, DM, DM, X, DM, modl + 2 * DM, nullptr);
        k_norm_mod<<<M, 256, 0, stream>>>(X, modl, 3, 4, XN);
        k_gemm<2><<<dim3(DFF / 128, M / 128), 256, 0, stream>>>(XN, (bf16_t*)(ws + WS_WFF1) + (size_t)l * DM * DFF, DM, DFF, nullptr, DFF, nullptr, FF);
        k_gemm<1><<<dim3(DM / 128, M / 128), 256, 0, stream>>>(FF, (bf16_t*)(ws + WS_WFF2) + (size_t)l * DM * DFF, DFF, DM, X, DM, modl + 5 * DM, nullptr);
    }
}
extern "C" void kernel_launch(void* const* d_in, const int* in_sizes, int n_in, void* d_out, int out_size, void* d_ws, size_t ws_size, hipStream_t stream) {
    if (n_in != 17 || out_size != M * DM || ws_size < WS_END) { fprintf(stderr, "kernel_launch: unexpected shapes n_in %d out %d ws %zu (need %zu)\n", n_in, out_size, ws_size, (size_t)WS_END); return; }
    naive_forward(d_in, (float*)d_out, (unsigned char*)d_ws, stream, 0, DEPTH, true);
}
```

```cpp
#include <hip/hip_runtime.h>
#include <cstdio>
#include <cstdint>
#include <cmath>

constexpr int DM = 2048, BATCH = 4, SEQ = 2048, DEPTH = 4, M = BATCH * SEQ, DFF = 4 * DM;
constexpr int CHUNK = 64, TOPK = 256;
constexpr int NIN = 6216, NINP = 6400;
constexpr int OFF_AQ = 0, OFF_AK = 1024, OFF_AV = 2048, OFF_BU = 3072, OFF_BV = 3584, OFF_CQ = 4096, OFF_CK = 4608, OFF_CV = 5120, OFF_IQ = 5632, OFF_IK = 6144, OFF_IW = 6208;
constexpr float EPS = 1e-6f, ROPE_THETA = 10000.0f;
constexpr float QSCALE = 0.08838834764831845f * 1.4426950408889634f;
constexpr float IWSCALE = 0.35355339059327373f * 0.125f;
enum { I_X = 0, I_C, I_WMOD, I_BMOD, I_WIN, I_WOUT, I_AQN, I_AKN, I_ALAM, I_ASUB, I_BVN, I_BWS, I_BBIAS, I_CQN, I_CKN, I_WFF1, I_WFF2 };

constexpr size_t MiB = 1u << 20;
constexpr size_t WS_CTL = 0, CTL_ZERO_BYTES = 1 * MiB;
constexpr size_t WS_MOD = 1 * MiB;
constexpr size_t WS_WIN = 2 * MiB;
constexpr size_t WS_WOUT = WS_WIN + 100 * MiB;
constexpr size_t WS_WFF1 = WS_WOUT + 32 * MiB;
constexpr size_t WS_WFF2 = WS_WFF1 + 128 * MiB;
constexpr size_t WS_XN = WS_WFF2 + 128 * MiB;
constexpr size_t WS_AQ = WS_XN + 32 * MiB, WS_AK = WS_AQ + 16 * MiB, WS_AV = WS_AK + 16 * MiB;
constexpr size_t WS_BU = WS_AV + 16 * MiB, WS_BV = WS_BU + 8 * MiB, WS_CQ = WS_BV + 8 * MiB, WS_CK = WS_CQ + 8 * MiB, WS_CV = WS_CK + 8 * MiB, WS_IQ = WS_CV + 8 * MiB;
constexpr size_t WS_IK = WS_IQ + 8 * MiB;
constexpr size_t WS_IW = WS_IK + 1 * MiB;
constexpr size_t WS_SEL = WS_IW + 1 * MiB;
constexpr size_t WS_MIX = WS_SEL + 2 * MiB;
constexpr size_t WS_OA = WS_MIX + 32 * MiB;
constexpr size_t WS_FF = WS_OA + 64 * MiB;
constexpr size_t WS_ROPE = WS_FF + 128 * MiB;
constexpr size_t WS_LAM = WS_ROPE + 1536 * 1024;
constexpr size_t WS_GAINS = WS_ROPE + 1536 * 1024 + 4096;
constexpr size_t WS_SMALL = WS_ROPE + 1536 * 1024 + 4096 + 16384;
constexpr size_t WS_BWSB = WS_ROPE + 1536 * 1024 + 65536;
constexpr int EPI_LDS_OFF = 131072;
constexpr size_t WS_PROJ = WS_ROPE + 2 * MiB;
constexpr size_t WS_WINN = WS_PROJ + 200 * MiB;
constexpr size_t WS_END = WS_WINN + 25 * MiB;
#define GAS __attribute__((address_space(1)))
#define LAS __attribute__((address_space(3)))
typedef unsigned short bf16;
typedef unsigned v4u __attribute__((ext_vector_type(4)));
typedef float f32x4 __attribute__((ext_vector_type(4)));
typedef short bf16x8 __attribute__((ext_vector_type(8)));
typedef GAS unsigned gu32;
typedef GAS unsigned long long gu64;
#define RLX_AGENT __ATOMIC_RELAXED, __HIP_MEMORY_SCOPE_AGENT
#define LDS_WAIT() asm volatile("s_waitcnt lgkmcnt(0)" ::: "memory")
#define VM_WAIT() asm volatile("s_waitcnt vmcnt(0)" ::: "memory")
__device__ __forceinline__ unsigned long long rt() { return __builtin_amdgcn_s_memrealtime(); }
__device__ __forceinline__ unsigned f2bf(float f) { unsigned u = __builtin_bit_cast(unsigned, f); return (u + 0x7fffu + ((u >> 16) & 1u)) >> 16; }
__device__ __forceinline__ unsigned pk2(float lo, float hi) { return f2bf(lo) | (f2bf(hi) << 16); }

#define XB_TMO      128
#define XB_XCNT(j)  (256  + 64 * (j))
#define XB_XSUB(j)  (1280 + 64 * (j))
#define XB_XGEN(j)  (2304 + 64 * (j))
#define XB_TOP      3328
#define XB_TOPGEN   3392
#define XCD_BAR_WORDS 3456
#define XB_SPIN_CAP (1u << 18)

__device__ __forceinline__ unsigned xb_ld(unsigned* p)              { return __hip_atomic_load(p, __ATOMIC_RELAXED, __HIP_MEMORY_SCOPE_AGENT); }
__device__ __forceinline__ unsigned xb_add(unsigned* p, unsigned v) { return __hip_atomic_fetch_add(p, v, __ATOMIC_RELAXED, __HIP_MEMORY_SCOPE_AGENT); }
__device__ __forceinline__ unsigned xb_xcc_id() { return (unsigned)__builtin_amdgcn_s_getreg((3 << 11) | 20) & 0xFu; }
#define XB_SPIN(cond, bar) do { unsigned _sp = 0; while (cond) { __builtin_amdgcn_s_sleep(1); \
    if ((++_sp & 255u) == 0u) { if (xb_ld(&(bar)[XB_TMO])) break; if (_sp > XB_SPIN_CAP) { atomicAdd(&(bar)[XB_TMO], 1u); break; } } } } while (0)

struct XcdBarrier {
    unsigned* bar; unsigned x;
    volatile LAS unsigned* st;
};

__device__ __forceinline__ XcdBarrier xcd_barrier_post(unsigned* bar, volatile LAS unsigned* st) {
    XcdBarrier b; b.bar = bar; b.x = xb_xcc_id(); b.st = st;
    if (threadIdx.x == 0) (void)xb_add(&bar[XB_XCNT(b.x)], 1u);
    return b;
}
__device__ __forceinline__ void xcd_barrier_complete(unsigned* bar, unsigned x, unsigned& nloc, unsigned& nx) {
    const unsigned G = gridDim.x * gridDim.y * gridDim.z;
    unsigned sum, cnt, mine, sp = 0u;
    for (;;) {
        sum = 0u; cnt = 0u; mine = 0u;
#pragma unroll
        for (unsigned j = 0; j < 16; ++j) { const unsigned c = xb_ld(&bar[XB_XCNT(j)]); sum += c; cnt += (c > 0u) ? 1u : 0u; mine = (j == x) ? c : mine; }
        if (sum == G) break;
        __builtin_amdgcn_s_sleep(1);
        if ((++sp & 255u) == 0u) { if (xb_ld(&bar[XB_TMO])) break; if (sp > XB_SPIN_CAP) { atomicAdd(&bar[XB_TMO], 1u); break; } }
    }
    nloc = mine > 0u ? mine : 1u; nx = cnt > 0u ? cnt : 1u;
}

__device__ __forceinline__ void xcd_barrier(const XcdBarrier& b) {
    asm volatile("s_waitcnt vmcnt(0)" ::: "memory");
    __syncthreads();
    if (threadIdx.x == 0) {
        unsigned* bar = b.bar;
        __builtin_amdgcn_s_waitcnt(0);
        unsigned nloc = b.st[0], nx = b.st[1];
        if (nloc == 0u) { xcd_barrier_complete(bar, b.x, nloc, nx); b.st[0] = nloc; b.st[1] = nx; }
        const unsigned old = xb_add(&bar[XB_XSUB(b.x)], 1u);
        const unsigned gen = old / nloc;
        if (old + 1u == (gen + 1u) * nloc) {
            __builtin_amdgcn_fence(__ATOMIC_RELEASE, "agent");
            asm volatile("s_waitcnt vmcnt(0)" ::: "memory");
            const unsigned og = xb_add(&bar[XB_TOP], 1u);
            const unsigned tg = og / nx;
            if (og + 1u == (tg + 1u) * nx) xb_add(&bar[XB_TOPGEN], 1u);
            else XB_SPIN(xb_ld(&bar[XB_TOPGEN]) == tg, bar);
            __builtin_amdgcn_fence(__ATOMIC_ACQUIRE, "agent");
            xb_add(&bar[XB_XGEN(b.x)], 1u);
            asm volatile("s_waitcnt vmcnt(0)" ::: "memory");
        } else {
            XB_SPIN(xb_ld(&bar[XB_XGEN(b.x)]) == gen, bar);
            __builtin_amdgcn_fence(__ATOMIC_ACQUIRE, "agent");
            asm volatile("s_waitcnt vmcnt(0)" ::: "memory");
        }
    }
    __syncthreads();
}
namespace pg8 {
#define PG8_LAS __attribute__((address_space(3)))
typedef unsigned short bf16_t;
typedef short bf16x8 __attribute__((ext_vector_type(8)));
typedef float f32x4 __attribute__((ext_vector_type(4)));
typedef unsigned u32x4 __attribute__((ext_vector_type(4)));
constexpr int BM = 256, BK = 64, HALF = 128, HTB = HALF * BK * 2  , STAGE_BYTES = 8 * HTB, NXCD = 8, WGM = 8;

__host__ __device__ __forceinline__ int lds_byte(int r, int c) { const int st = (r >> 4) * 2 + (c >> 5), rr = r & 15, cc = c & 31, ob = rr * 64 + cc * 2; return st * 1024 + (ob ^ (((ob >> 9) & 1) << 5)); }
__host__ __device__ __forceinline__ void stage_rc(int b, int& R, int& C) { const int st = b / 1024, sb = b % 1024, swz = sb ^ (((sb >> 9) & 1) << 5); R = (st >> 1) * 16 + swz / 64; C = (st & 1) * 32 + (swz % 64) / 2; }
__host__ __device__ __forceinline__ int perm32(int rho) { const int n = rho >> 4, i = rho & 15; return 8 * (i >> 2) + 4 * n + (i & 3); }

struct Unit { int pm, pn; };
struct Gemm { const bf16_t* A; const bf16_t* Bt; int M, N, K; };

struct StaticOrder {
    int nM, nN, nwg, G, c;
    __host__ __device__ void init(int M, int N, int G_, int c_) { nM = M / BM; nN = N / BM; nwg = nM * nN; G = G_; c = c_; }
    __host__ __device__ bool next(int i, Unit& u) const {
        const long L = (long)i * G + c; if (L >= nwg) return false;
        int wgid = (int)L; { const int q = nwg / NXCD, r = nwg % NXCD, xcd = wgid % NXCD, off = wgid / NXCD; wgid = (xcd < r ? xcd * (q + 1) : r * (q + 1) + (xcd - r) * q) + off; }
        const int nig = WGM * nN, gid = wgid / nig, fm = gid * WGM, gsz = (nM - fm) < WGM ? (nM - fm) : WGM;
        u.pm = fm + ((wgid % nig) % gsz); u.pn = (wgid % nig) / gsz; return true;
    }
    __device__ __forceinline__ void a_ready(const Unit&) const {}
    __device__ __forceinline__ void done(const Unit&) const {}
};

__device__ __forceinline__ unsigned cvt_pk_bf16(float lo, float hi) { unsigned r; asm volatile("v_cvt_pk_bf16_f32 %0, %1, %2" : "=v"(r) : "v"(lo), "v"(hi)); return r; }
typedef float f32x2 __attribute__((ext_vector_type(2)));
template <class Epi, class Sched, bool ALIGN_EPI = false, bool SP2 = false>
__device__ __forceinline__ void gemm_phase(PG8_LAS unsigned char* lds, const Gemm g, const Sched& S, const Epi& E) {
    int tid_ = threadIdx.x; asm volatile("" : "+v"(tid_));
    const int tid = tid_, wid = __builtin_amdgcn_readfirstlane(tid >> 6), lane = tid & 63, wr = wid >> 2, wc = wid & 3, fr = lane & 15, fq = lane >> 4;
    const int K = g.K, nt = K / BK;
    unsigned voffA[2], voffB[2];
#pragma unroll
    for (int i = 0; i < 2; ++i) { int R, C; stage_rc(tid * 16 + i * 8192, R, C); const int Rb = Epi::PERM ? ((R & ~31) + perm32(R & 31)) : R;
        voffA[i] = (unsigned)(R * K + C) * 2u; voffB[i] = (unsigned)(Rb * K + C) * 2u; }
    const size_t kstep = (size_t)(BK * 2);
    const size_t hstep = (size_t)HALF * K * 2;
    const size_t tstep = 2 * hstep;
    const unsigned ldsw = (unsigned)wid * 1024u;
    const int aoff = lds_byte(wr * 64 + fr, fq * 8), boff = lds_byte(wc * 32 + fr, fq * 8);
#define PG8_SA(b, h) (((b) * 2 + (h)) * HTB)
#define PG8_SB(b, h) ((4 + (b) * 2 + (h)) * HTB)
#define PG8_STAGE(bufoff, gbase, voff) do { _Pragma("unroll") for (int _i = 0; _i < 2; ++_i) \
        __builtin_amdgcn_global_load_lds((const unsigned*)((const char*)(gbase) + (voff)[_i]), (PG8_LAS unsigned*)(lds + (bufoff) + ldsw + _i * 8192), 16, 0, 0); } while (0)
#define PG8_LDA(dst, b, h) do { _Pragma("unroll") for (int m = 0; m < 4; ++m) _Pragma("unroll") for (int k = 0; k < 2; ++k) dst[m][k] = *(const PG8_LAS bf16x8*)(lds + PG8_SA(b, h) + aoff + m * 2048 + k * 1024); } while (0)
#define PG8_LDB(dst, b, h) do { _Pragma("unroll") for (int n = 0; n < 2; ++n) _Pragma("unroll") for (int k = 0; k < 2; ++k) dst[n][k] = *(const PG8_LAS bf16x8*)(lds + PG8_SB(b, h) + boff + n * 2048 + k * 1024); } while (0)
#define PG8_MMA(ai, bj, At, Bt) do { __builtin_amdgcn_s_setprio(1); _Pragma("unroll") for (int m = 0; m < 4; ++m) _Pragma("unroll") for (int n = 0; n < 2; ++n) _Pragma("unroll") for (int k = 0; k < 2; ++k) \
        acc[ai][bj][m][n] = __builtin_amdgcn_mfma_f32_16x16x32_bf16(Bt[n][k], At[m][k], acc[ai][bj][m][n], 0, 0, 0); __builtin_amdgcn_s_setprio(0); } while (0)
#define PG8_WAIT_V(n) asm volatile("s_waitcnt vmcnt(" #n ")" ::: "memory")
#define PG8_WAIT_L(n) asm volatile("s_waitcnt lgkmcnt(" #n ")" ::: "memory")
#define PG8_BAR __builtin_amdgcn_s_barrier()
#define PG8_SCHED __builtin_amdgcn_sched_barrier(0)
    Unit cur, nxt; int ui = 0;
    if (!S.next(0, cur)) return;
    f32x4 acc[2][2][4][2];
#pragma unroll
    for (int a = 0; a < 2; ++a)
#pragma unroll
        for (int b = 0; b < 2; ++b)
#pragma unroll
            for (int m = 0; m < 4; ++m)
#pragma unroll
                for (int n = 0; n < 2; ++n) acc[a][b][m][n] = (f32x4){0.f, 0.f, 0.f, 0.f};
    bf16x8 At[4][2], B0[2][2], B1[2][2];
    const char* cA = (const char*)g.A + (size_t)cur.pm * tstep; const char* cB = (const char*)g.Bt + (size_t)cur.pn * tstep;
    S.a_ready(cur);
    if constexpr (SP2) {
        PG8_STAGE(PG8_SB(0, 0), cB, voffB); PG8_STAGE(PG8_SB(0, 1), cB + hstep, voffB); PG8_STAGE(PG8_SA(0, 0), cA, voffA); PG8_STAGE(PG8_SA(0, 1), cA + hstep, voffA);
        if (wr == 1) PG8_BAR;
        PG8_WAIT_V(2); PG8_BAR;
        PG8_STAGE(PG8_SB(1, 0), cB + kstep, voffB); PG8_STAGE(PG8_SA(1, 0), cA + kstep, voffA); PG8_STAGE(PG8_SB(1, 1), cB + hstep + kstep, voffB);
        PG8_WAIT_V(6); PG8_BAR;
    } else {
        PG8_STAGE(PG8_SB(0, 0), cB, voffB); PG8_STAGE(PG8_SA(0, 0), cA, voffA); PG8_STAGE(PG8_SB(0, 1), cB + hstep, voffB); PG8_STAGE(PG8_SA(0, 1), cA + hstep, voffA);
        if (wr == 1) PG8_BAR;
        PG8_WAIT_V(4); PG8_BAR;
        PG8_STAGE(PG8_SB(1, 0), cB + kstep, voffB); PG8_STAGE(PG8_SA(1, 0), cA + kstep, voffA); PG8_STAGE(PG8_SB(1, 1), cB + hstep + kstep, voffB);
        PG8_WAIT_V(6); PG8_BAR;
    }
    for (;;) {
        const bool has_next = S.next(ui + 1, nxt);
        const char* nA = has_next ? (const char*)g.A + (size_t)nxt.pm * tstep : cA; const char* nB = has_next ? (const char*)g.Bt + (size_t)nxt.pn * tstep : cB;
        for (int t = 0; t < nt; t += 2) {
            const bool last = (t == nt - 2);
            const char* a1 = cA + (size_t)(t + 1) * kstep;
            const char* a2 = last ? nA : cA + (size_t)(t + 2) * kstep; const char* b2 = last ? nB : cB + (size_t)(t + 2) * kstep;
            const char* a3 = a2 + kstep; const char* b3 = b2 + kstep;
            if (last && has_next) S.a_ready(nxt);
            if constexpr (SP2) {
            PG8_LDB(B0, 0, 0); PG8_LDB(B1, 0, 1); PG8_SCHED; PG8_LDA(At, 0, 0); PG8_STAGE(PG8_SA(1, 1), a1 + hstep, voffA);
            PG8_WAIT_V(8); PG8_WAIT_L(0); PG8_BAR; PG8_MMA(0, 0, At, B0); PG8_MMA(0, 1, At, B1); PG8_BAR; PG8_SCHED;
            PG8_LDA(At, 0, 1); PG8_STAGE(PG8_SB(0, 0), b2, voffB); PG8_STAGE(PG8_SB(0, 1), b2 + hstep, voffB); PG8_STAGE(PG8_SA(0, 0), a2, voffA);
            PG8_WAIT_V(8); PG8_WAIT_L(0); PG8_BAR; PG8_MMA(1, 0, At, B0); PG8_MMA(1, 1, At, B1); PG8_BAR; PG8_SCHED;
            PG8_LDB(B0, 1, 0); PG8_LDB(B1, 1, 1); PG8_SCHED; PG8_LDA(At, 1, 0); PG8_STAGE(PG8_SA(0, 1), a2 + hstep, voffA);
            PG8_WAIT_V(8); PG8_WAIT_L(0); PG8_BAR; PG8_MMA(0, 0, At, B0); PG8_MMA(0, 1, At, B1); PG8_BAR; PG8_SCHED;
            PG8_LDA(At, 1, 1); PG8_STAGE(PG8_SB(1, 0), b3, voffB); PG8_STAGE(PG8_SB(1, 1), b3 + hstep, voffB); PG8_STAGE(PG8_SA(1, 0), a3, voffA);
            PG8_WAIT_V(8); PG8_WAIT_L(0); PG8_BAR; PG8_MMA(1, 0, At, B0); PG8_MMA(1, 1, At, B1); PG8_BAR; PG8_SCHED;
            } else {
            PG8_LDB(B0, 0, 0); PG8_SCHED; PG8_LDA(At, 0, 0); PG8_STAGE(PG8_SA(1, 1), a1 + hstep, voffA);
            PG8_WAIT_L(8); PG8_BAR; PG8_WAIT_L(0); PG8_MMA(0, 0, At, B0); PG8_BAR; PG8_SCHED;
            PG8_LDB(B1, 0, 1); PG8_STAGE(PG8_SB(0, 0), b2, voffB);
            PG8_BAR; PG8_WAIT_L(0); PG8_MMA(0, 1, At, B1); PG8_BAR;
            PG8_LDA(At, 0, 1); PG8_STAGE(PG8_SA(0, 0), a2, voffA);
            PG8_BAR; PG8_WAIT_L(0); PG8_MMA(1, 0, At, B0); PG8_BAR; PG8_SCHED;
            PG8_STAGE(PG8_SB(0, 1), b2 + hstep, voffB);
            PG8_WAIT_V(6); PG8_BAR; PG8_MMA(1, 1, At, B1); PG8_BAR;
            PG8_LDB(B0, 1, 0); PG8_SCHED; PG8_LDA(At, 1, 0); PG8_STAGE(PG8_SA(0, 1), a2 + hstep, voffA);
            PG8_WAIT_L(8); PG8_BAR; PG8_WAIT_L(0); PG8_MMA(0, 0, At, B0); PG8_BAR; PG8_SCHED;
            PG8_LDB(B1, 1, 1); PG8_STAGE(PG8_SB(1, 0), b3, voffB);
            PG8_BAR; PG8_WAIT_L(0); PG8_MMA(0, 1, At, B1); PG8_BAR;
            PG8_LDA(At, 1, 1); PG8_STAGE(PG8_SA(1, 0), a3, voffA);
            PG8_BAR; PG8_WAIT_L(0); PG8_MMA(1, 0, At, B0); PG8_BAR; PG8_SCHED;
            PG8_STAGE(PG8_SB(1, 1), b3 + hstep, voffB);
            PG8_WAIT_V(6); PG8_BAR; PG8_MMA(1, 1, At, B1); PG8_BAR;
            }
        }
        if constexpr (ALIGN_EPI) { if (wr == 0) PG8_BAR; }
        if constexpr (!Epi::AFTER_DRAIN) { E(acc, cur, wr, wc, fr, fq); S.done(cur); }
        if (!has_next) break;
#pragma unroll
        for (int a = 0; a < 2; ++a)
#pragma unroll
            for (int b = 0; b < 2; ++b)
#pragma unroll
                for (int m = 0; m < 4; ++m)
#pragma unroll
                    for (int n = 0; n < 2; ++n) acc[a][b][m][n] = (f32x4){0.f, 0.f, 0.f, 0.f};
        cur = nxt; cA = nA; cB = nB; ++ui;
        if constexpr (ALIGN_EPI) { if (wr == 1) PG8_BAR; }
    }
    PG8_WAIT_V(0);
    if constexpr (!ALIGN_EPI) { if (wr == 0) PG8_BAR; }
    PG8_BAR;
    if constexpr (Epi::AFTER_DRAIN) { E.fused(acc, cur, wr, wc, fr, fq, lds, wid, lane); S.done(cur); }
#undef PG8_SA
#undef PG8_SB
#undef PG8_STAGE
#undef PG8_LDA
#undef PG8_LDB
#undef PG8_MMA
#undef PG8_WAIT_V
#undef PG8_WAIT_L
#undef PG8_BAR
#undef PG8_SCHED
}
}
namespace pg8 {
typedef float f32x2 __attribute__((ext_vector_type(2)));
__device__ __forceinline__ float gelu_tanh_fast(float x) {
    const float u = x * (0.7978845608028654f + 0.035677408136300125f * x * x);
    const float e = __builtin_amdgcn_exp2f(-2.8853900817779268f * u);
    return x * __builtin_amdgcn_rcpf(1.0f + e);
}
__device__ __forceinline__ u32x4 pack8(const f32x4& a, const f32x4& b) { u32x4 w; w.x = cvt_pk_bf16(a[0], a[1]); w.y = cvt_pk_bf16(a[2], a[3]); w.z = cvt_pk_bf16(b[0], b[1]); w.w = cvt_pk_bf16(b[2], b[3]); return w; }

struct EpiIn {
    static constexpr bool PERM = true, AFTER_DRAIN = false;
    unsigned char* ws; int l; PG8_LAS unsigned char* ldsb;
    __device__ __forceinline__ void operator()(f32x4 (&acc)[2][2][4][2], const Unit& u, int wr, int wc, int fr, int fq) const {
        bf16_t* const AQ = (bf16_t*)(ws + WS_AQ); bf16_t* const AK = (bf16_t*)(ws + WS_AK); bf16_t* const AV = (bf16_t*)(ws + WS_AV); bf16_t* const BU = (bf16_t*)(ws + WS_BU); bf16_t* const BV = (bf16_t*)(ws + WS_BV);
        bf16_t* const CQ = (bf16_t*)(ws + WS_CQ); bf16_t* const CK = (bf16_t*)(ws + WS_CK); bf16_t* const CV = (bf16_t*)(ws + WS_CV); bf16_t* const IQ = (bf16_t*)(ws + WS_IQ); bf16_t* const IK = (bf16_t*)(ws + WS_IK);
        float* const IW = (float*)(ws + WS_IW);
        const float* const gl = (const float*)(ws + WS_GAINS) + l * 1024;
        const float* const aqn = gl; const float* const akn = gl + 128; const float* const cqn = gl + 256; const float* const ckn = gl + 384; const float* const bvn = gl + 512;
        const float* const rope128 = (const float*)(ws + WS_ROPE); const float* const rope64 = rope128 + SEQ * 64 * 2;
        PG8_LAS float* const P = (PG8_LAS float*)(ldsb + EPI_LDS_OFF);
        const int pn = u.pn, row0 = u.pm * BM + wr * 64 + fr;
        const bool qk = (pn < 8) || (pn >= 16 && pn < 20), bv = (pn == 14 || pn == 15);
        if (qk || bv) {
            if (bv) {
#pragma unroll
                for (int ai = 0; ai < 2; ++ai)
#pragma unroll
                    for (int bj = 0; bj < 2; ++bj)
#pragma unroll
                        for (int m = 0; m < 4; ++m)
#pragma unroll
                            for (int n = 0; n < 2; ++n)
#pragma unroll
                                for (int e = 0; e < 4; ++e) acc[ai][bj][m][n][e] = gelu_tanh_fast(acc[ai][bj][m][n][e]);
            }
#pragma unroll
            for (int ai = 0; ai < 2; ++ai)
#pragma unroll
                for (int m = 0; m < 4; ++m) {
                    float s = 0.f;
#pragma unroll
                    for (int bj = 0; bj < 2; ++bj)
#pragma unroll
                        for (int n = 0; n < 2; ++n) { const f32x4 x = acc[ai][bj][m][n]; s += (x[0] * x[0] + x[1] * x[1]) + (x[2] * x[2] + x[3] * x[3]); }
                    s += __shfl_xor(s, 16); s += __shfl_xor(s, 32);
                    if (fq == 0) P[(ai * HALF + wr * 64 + m * 16 + fr) * 4 + wc] = s;
                }
            asm volatile("s_waitcnt lgkmcnt(0)" ::: "memory"); __builtin_amdgcn_s_barrier(); asm volatile("" ::: "memory");
            const int hv = wc >> 1, d0b = 32 * (wc & 1) + 8 * fq;
            const float* gain; bf16_t* dst; int pitch, tl; float qs = 1.f;
            if (pn < 4) { gain = aqn; dst = AQ; pitch = 1024; tl = pn; qs = QSCALE; }
            else if (pn < 8) { gain = akn; dst = AK; pitch = 1024; tl = pn - 4; }
            else if (pn < 16) { gain = bvn + (pn - 14) * 256 + hv * 128; dst = BV; pitch = 512; tl = pn - 14; }
            else if (pn < 18) { gain = cqn; dst = CQ; pitch = 512; tl = pn - 16; qs = QSCALE; }
            else { gain = ckn; dst = CK; pitch = 512; tl = pn - 18; }
            const f32x4 g00 = *(const f32x4*)(gain + d0b), g01 = *(const f32x4*)(gain + d0b + 4), g10 = *(const f32x4*)(gain + 64 + d0b), g11 = *(const f32x4*)(gain + 64 + d0b + 4);
            const int colb = tl * 256 + hv * 128 + d0b;
#pragma unroll
            for (int ai = 0; ai < 2; ++ai)
#pragma unroll
                for (int m = 0; m < 4; ++m) {
                    const int rl = ai * HALF + wr * 64 + m * 16 + fr, row = row0 + ai * HALF + m * 16;
                    const float tot = P[rl * 4 + wc] + P[rl * 4 + (wc ^ 1)];
                    const float rs = __builtin_amdgcn_rsqf(tot * (1.f / 128.f) + EPS);
                    f32x4 x00 = acc[ai][0][m][0] * rs * g00, x01 = acc[ai][0][m][1] * rs * g01, x10 = acc[ai][1][m][0] * rs * g10, x11 = acc[ai][1][m][1] * rs * g11;
                    bf16_t* o = dst + (size_t)row * pitch + colb;
                    if (!bv) {
                        const f32x4* rp = (const f32x4*)(rope128 + ((size_t)(row & (SEQ - 1)) * 64 + d0b) * 2);
                        const f32x4 c0 = rp[0], c1 = rp[1], c2 = rp[2], c3 = rp[3];
                        const f32x4 cs0 = {c0[0], c0[2], c1[0], c1[2]}, sn0 = {c0[1], c0[3], c1[1], c1[3]}, cs1 = {c2[0], c2[2], c3[0], c3[2]}, sn1 = {c2[1], c2[3], c3[1], c3[3]};
                        const f32x4 y00 = (x00 * cs0 - x10 * sn0) * qs, y10 = (x10 * cs0 + x00 * sn0) * qs, y01 = (x01 * cs1 - x11 * sn1) * qs, y11 = (x11 * cs1 + x01 * sn1) * qs;
                        x00 = y00; x10 = y10; x01 = y01; x11 = y11;
                    }
                    *(u32x4*)o = pack8(x00, x01); *(u32x4*)(o + 64) = pack8(x10, x11);
                    asm volatile("" ::: "memory");
                }
        } else if (pn == 22 || pn == 23 || pn == 24) {
            if (pn < 24 || wc == 0) {
                bf16_t* dst = pn < 24 ? IQ : IK; const int pitch = pn < 24 ? 512 : 64, colb = (pn < 24 ? (pn - 22) * 256 + wc * 64 : 0) + 8 * fq;
#pragma unroll
                for (int ai = 0; ai < 2; ++ai)
#pragma unroll
                    for (int m = 0; m < 4; ++m) {
                        const int row = row0 + ai * HALF + m * 16;
                        const f32x4* rp = (const f32x4*)(rope64 + ((size_t)(row & (SEQ - 1)) * 32 + 8 * fq) * 2);
                        const f32x4 c0 = rp[0], c1 = rp[1], c2 = rp[2], c3 = rp[3];
                        const f32x4 cs0 = {c0[0], c0[2], c1[0], c1[2]}, sn0 = {c0[1], c0[3], c1[1], c1[3]}, cs1 = {c2[0], c2[2], c3[0], c3[2]}, sn1 = {c2[1], c2[3], c3[1], c3[3]};
                        const f32x4 x00 = acc[ai][0][m][0], x01 = acc[ai][0][m][1], x10 = acc[ai][1][m][0], x11 = acc[ai][1][m][1];
                        const f32x4 y00 = x00 * cs0 - x10 * sn0, y10 = x10 * cs0 + x00 * sn0, y01 = x01 * cs1 - x11 * sn1, y11 = x11 * cs1 + x01 * sn1;
                        bf16_t* o = dst + (size_t)row * pitch + colb;
                        *(u32x4*)o = pack8(y00, y01); *(u32x4*)(o + 32) = pack8(y10, y11);
                        asm volatile("" ::: "memory");
                    }
            } else if (wc == 1 && fq == 0) {
#pragma unroll
                for (int ai = 0; ai < 2; ++ai)
#pragma unroll
                    for (int m = 0; m < 4; ++m) { float* o = IW + (size_t)(row0 + ai * HALF + m * 16) * 8; *(f32x4*)o = acc[ai][0][m][0] * IWSCALE; *(f32x4*)(o + 4) = acc[ai][0][m][1] * IWSCALE; }
            }
        } else {
            bf16_t* dst; int pitch, tl; const bool g = (pn == 12 || pn == 13);
            if (pn < 12) { dst = AV; pitch = 1024; tl = pn - 8; } else if (pn < 14) { dst = BU; pitch = 512; tl = pn - 12; } else { dst = CV; pitch = 512; tl = pn - 20; }
            const int colb = tl * 256 + wc * 32 + 8 * fq;
#pragma unroll
            for (int ai = 0; ai < 2; ++ai)
#pragma unroll
                for (int m = 0; m < 4; ++m) { bf16_t* o = dst + (size_t)(row0 + ai * HALF + m * 16) * pitch + colb;
#pragma unroll
                    for (int bj = 0; bj < 2; ++bj) { f32x4 v0 = acc[ai][bj][m][0], v1 = acc[ai][bj][m][1];
                        if (g) {
#pragma unroll
                            for (int e = 0; e < 4; ++e) { v0[e] = gelu_tanh_fast(v0[e]); v1[e] = gelu_tanh_fast(v1[e]); } }
                        *(u32x4*)(o + bj * HALF) = pack8(v0, v1); } }
        }
    }
};
__host__ __device__ __forceinline__ void in_src_block(int p32, int& src, int& cnt) {
    const int pn = p32 >> 3, pb = p32 & 7, bj = pb >> 2, wc = pb & 3; cnt = 32;
    if (pn < 8 || (pn >= 14 && pn < 20)) src = pn * 256 + (4 * (wc >> 1) + 2 * bj + (wc & 1)) * 32;
    else if (pn == 22 || pn == 23) src = pn * 256 + (2 * wc + bj) * 32;
    else if (pn == 24) { if (pb == 0) src = OFF_IK; else if (pb == 4) src = OFF_IK + 32; else if (pb == 1) { src = OFF_IW; cnt = 8; } else { src = 0; cnt = 0; } }
    else src = pn * 256 + pb * 32;
}

struct EpiRes {
    static constexpr bool PERM = false, AFTER_DRAIN = false;
    const float* base; float* out; const float* gate;
    __device__ __forceinline__ void operator()(f32x4 (&acc)[2][2][4][2], const Unit& u, int wr, int wc, int fr, int fq) const {
        const int row0 = u.pm * BM + wr * 64 + fr, col0 = u.pn * BM + wc * 32 + 4 * fq;
        const float* g = gate + (size_t)((u.pm * BM) / SEQ) * 6 * DM + col0;
        f32x4 gv[2][2];
#pragma unroll
        for (int bj = 0; bj < 2; ++bj)
#pragma unroll
            for (int n = 0; n < 2; ++n) gv[bj][n] = *(const f32x4*)(g + bj * HALF + n * 16);
#pragma unroll
        for (int ai = 0; ai < 2; ++ai)
#pragma unroll
            for (int m = 0; m < 4; ++m) { const size_t off = (size_t)(row0 + ai * HALF + m * 16) * DM + col0;
#pragma unroll
                for (int bj = 0; bj < 2; ++bj)
#pragma unroll
                    for (int n = 0; n < 2; ++n) { const f32x4 b = *(const f32x4*)(base + off + bj * HALF + n * 16); *(f32x4*)(out + off + bj * HALF + n * 16) = b + gv[bj][n] * acc[ai][bj][m][n]; } }
    }
};
struct EpiRelu2 {
    static constexpr bool PERM = true, AFTER_DRAIN = false;
    bf16_t* O; int ldc;
    __device__ __forceinline__ void operator()(f32x4 (&acc)[2][2][4][2], const Unit& u, int wr, int wc, int fr, int fq) const {
        const int row0 = u.pm * BM + wr * 64 + fr, col0 = u.pn * BM + wc * 32 + 8 * fq;
#pragma unroll
        for (int ai = 0; ai < 2; ++ai)
#pragma unroll
            for (int m = 0; m < 4; ++m) { bf16_t* o = O + (size_t)(row0 + ai * HALF + m * 16) * ldc + col0;
#pragma unroll
                for (int bj = 0; bj < 2; ++bj) { f32x4 v0 = acc[ai][bj][m][0], v1 = acc[ai][bj][m][1];
#pragma unroll
                    for (int e = 0; e < 4; ++e) { const float a = fmaxf(v0[e], 0.f), b = fmaxf(v1[e], 0.f); v0[e] = a * a; v1[e] = b * b; }
                    *(u32x4*)(o + bj * HALF) = pack8(v0, v1); } }
    }
};
}
namespace at {
using bf16x8 = __attribute__((ext_vector_type(8))) short;
using s16x4  = __attribute__((ext_vector_type(4))) short;
using f32x16 = __attribute__((ext_vector_type(16))) float;
using u32x4  = __attribute__((ext_vector_type(4))) unsigned;
typedef unsigned short bf16_t;
constexpr int D = 128, NW = 8, QBLK = 32, KVBLK = 64;
constexpr int SHM_V = KVBLK * D * 2, SHM_K = KVBLK * D * 2, SHM_ATTN = 2 * SHM_V + 2 * SHM_K + NW * 64 * 4;
constexpr float THR_L2 = 8.f;
#define AT_KSWZ(row, colB) ((row) * 256 + ((colB) ^ (((row) & 7) << 4)))
#define AT_SBAR() __builtin_amdgcn_sched_barrier(0)
__device__ __forceinline__ int crow(int r, int hi) { return (r & 3) + 8 * (r >> 2) + 4 * hi; }
__device__ __forceinline__ unsigned cvtpk(float lo, float hi) { unsigned r; asm volatile("v_cvt_pk_bf16_f32 %0, %1, %2" : "=v"(r) : "v"(lo), "v"(hi)); return r; }

__device__ __forceinline__ void partialSM(f32x16& p0, f32x16& p1, float& m_reg, float& mn, float& alpha) {
  float pmax = p0[0];
#pragma unroll
  for (int r = 1; r < 16; ++r) pmax = fmaxf(pmax, p0[r]);
#pragma unroll
  for (int r = 0; r < 16; ++r) pmax = fmaxf(pmax, p1[r]);
  { auto rr = __builtin_amdgcn_permlane32_swap(__float_as_uint(pmax), __float_as_uint(pmax), false, false);
    pmax = fmaxf(__uint_as_float(rr[0]), __uint_as_float(rr[1])); }
  if (__builtin_expect(__all(pmax - m_reg <= THR_L2), 1)) { mn = m_reg; alpha = 1.f; }
  else { mn = fmaxf(m_reg, pmax); alpha = __builtin_amdgcn_exp2f(m_reg - mn); m_reg = mn; }
#pragma unroll
  for (int r = 0; r < 16; ++r) p0[r] = __builtin_amdgcn_exp2f(p0[r] - mn);
#pragma unroll
  for (int r = 0; r < 16; ++r) p1[r] = __builtin_amdgcn_exp2f(p1[r] - mn);
}
__device__ __forceinline__ void finishSM(f32x16& p0, f32x16& p1, float alpha, float& l_reg, bf16x8& pa0, bf16x8& pa1, bf16x8& pa2, bf16x8& pa3) {
  float ps = 0;
#pragma unroll
  for (int r = 0; r < 16; ++r) ps += p0[r];
#pragma unroll
  for (int r = 0; r < 16; ++r) ps += p1[r];
  { auto rr = __builtin_amdgcn_permlane32_swap(__float_as_uint(ps), __float_as_uint(ps), false, false);
    ps = __uint_as_float(rr[0]) + __uint_as_float(rr[1]); }
  l_reg = l_reg * alpha + ps;
#define AT_PK4(P, BASE, OUT) do { unsigned a0 = cvtpk(P[BASE + 0], P[BASE + 1]), a1 = cvtpk(P[BASE + 2], P[BASE + 3]);   \
    unsigned b0 = cvtpk(P[BASE + 4], P[BASE + 5]), b1 = cvtpk(P[BASE + 6], P[BASE + 7]);                              \
    auto r0 = __builtin_amdgcn_permlane32_swap(a0, b0, false, false); auto r1 = __builtin_amdgcn_permlane32_swap(a1, b1, false, false); \
    u32x4 w = {r0[0], r1[0], r0[1], r1[1]}; OUT = *reinterpret_cast<bf16x8*>(&w); } while (0)
  AT_PK4(p0, 0, pa0); AT_PK4(p0, 8, pa1); AT_PK4(p1, 0, pa2); AT_PK4(p1, 8, pa3);
#undef AT_PK4
}
__device__ __forceinline__ void qkt(f32x16& p0, f32x16& p1, const char* Ks, const bf16x8* qr, int r32, int hi) {
  p0 = f32x16{}; p1 = f32x16{};
#pragma unroll
  for (int d0 = 0; d0 < 8; ++d0) { const int cb = (d0 * 16 + hi * 8) * 2;
    bf16x8 b0 = *reinterpret_cast<const bf16x8*>(Ks + AT_KSWZ(r32, cb));
    bf16x8 b1 = *reinterpret_cast<const bf16x8*>(Ks + AT_KSWZ(32 + r32, cb));
    p0 = __builtin_amdgcn_mfma_f32_32x32x16_bf16(b0, qr[d0], p0, 0, 0, 0);
    p1 = __builtin_amdgcn_mfma_f32_32x32x16_bf16(b1, qr[d0], p1, 0, 0, 0); }
}
__device__ __forceinline__ int v_st(int k, int c) { const int kk = (k & ~0xC) | ((k & 4) << 1) | ((k & 8) >> 1); return ((kk >> 3) * 4 + (c >> 5)) * 512 + ((kk & 7) * 32 + (c & 31)) * 2; }
__device__ __forceinline__ int v_rd_base(int lane) { return ((lane & 3) << 3) | (((lane >> 2) & 3) << 6) | (((lane >> 4) & 1) << 5) | (((lane >> 5) & 1) << 8); }
constexpr int v_rd_off(int d0, int ks, int half) { return d0 * 512 + ks * 4096 + half * 2048; }
template <int OFF> __device__ __forceinline__ s16x4 tr_read(int vb) { s16x4 r; asm volatile("ds_read_b64_tr_b16 %0, %1 offset:%2" : "=&v"(r) : "v"(vb), "i"(OFF) : "memory"); return r; }
template <int D0> __device__ __forceinline__ void pv_one(f32x16& od, int vb, bf16x8 pa0, bf16x8 pa1, bf16x8 pa2, bf16x8 pa3) {
  const s16x4 l0 = tr_read<v_rd_off(D0, 0, 0)>(vb), h0 = tr_read<v_rd_off(D0, 0, 1)>(vb), l1 = tr_read<v_rd_off(D0, 1, 0)>(vb), h1 = tr_read<v_rd_off(D0, 1, 1)>(vb);
  const s16x4 l2 = tr_read<v_rd_off(D0, 2, 0)>(vb), h2 = tr_read<v_rd_off(D0, 2, 1)>(vb), l3 = tr_read<v_rd_off(D0, 3, 0)>(vb), h3 = tr_read<v_rd_off(D0, 3, 1)>(vb);
  asm volatile("s_waitcnt lgkmcnt(0)" ::: "memory"); AT_SBAR();
#define AT_PK(L, H) (bf16x8){L[0], L[1], L[2], L[3], H[0], H[1], H[2], H[3]}
  od = __builtin_amdgcn_mfma_f32_32x32x16_bf16(pa0, AT_PK(l0, h0), od, 0, 0, 0);
  od = __builtin_amdgcn_mfma_f32_32x32x16_bf16(pa1, AT_PK(l1, h1), od, 0, 0, 0);
  od = __builtin_amdgcn_mfma_f32_32x32x16_bf16(pa2, AT_PK(l2, h2), od, 0, 0, 0);
  od = __builtin_amdgcn_mfma_f32_32x32x16_bf16(pa3, AT_PK(l3, h3), od, 0, 0, 0);
#undef AT_PK
}
__device__ __forceinline__ void pv_d0(f32x16* o, int vb, bf16x8 pa0, bf16x8 pa1, bf16x8 pa2, bf16x8 pa3) {
  pv_one<0>(o[0], vb, pa0, pa1, pa2, pa3); pv_one<1>(o[1], vb, pa0, pa1, pa2, pa3); pv_one<2>(o[2], vb, pa0, pa1, pa2, pa3); pv_one<3>(o[3], vb, pa0, pa1, pa2, pa3);
}

template <int LDQ, int LDKV, bool MASKED, bool OUTBF>
__device__ __forceinline__ void attn_unit(const bf16_t* __restrict__ Qb, const bf16_t* __restrict__ Kh, const bf16_t* __restrict__ Vh, int qb, const unsigned* __restrict__ sel,
                                          float* __restrict__ Of, bf16_t* __restrict__ Ob, int ldo, char* lds) {
  int tid_ = threadIdx.x; asm volatile("" : "+v"(tid_));
  const int tid = tid_, wid = __builtin_amdgcn_readfirstlane(tid >> 6), lane = tid & 63, r32 = lane & 31, hi = lane >> 5;
  const int rb = wid < 4 ? wid : 11 - wid;
  const int NT = 4 * qb + 4, tmax = 4 * qb + (rb >> 1);
  char* V_lds = lds; char* K_lds = lds + 2 * SHM_V;
  float* ws = (float*)(lds + 2 * SHM_V + 2 * SHM_K) + wid * 64; float* li_l = ws; float* al_l = ws + 32;
  float m_reg = -1e30f, l_reg = 0; f32x16 o[4] = {}; bf16x8 qr[8];
  const bf16_t* Qw = Qb + (size_t)(rb * QBLK + r32) * LDQ + hi * 8;
#pragma unroll
  for (int d0 = 0; d0 < 8; ++d0) qr[d0] = *reinterpret_cast<const bf16x8*>(Qw + d0 * 16);
  const int sr = tid >> 4, sc = (tid & 15) * 8, vst0 = v_st(sr, sc), vst1 = v_st(32 + sr, sc);
  const int vb0 = (int)(uintptr_t)V_lds + v_rd_base(lane);
  bf16x8 vs0, vs1, ks0, ks1;
#define AT_SLOAD(k0) do { vs0 = *reinterpret_cast<const bf16x8*>(&Vh[(size_t)((k0) + sr) * LDKV + sc]); vs1 = *reinterpret_cast<const bf16x8*>(&Vh[(size_t)((k0) + 32 + sr) * LDKV + sc]); \
    ks0 = *reinterpret_cast<const bf16x8*>(&Kh[(size_t)((k0) + sr) * LDKV + sc]); ks1 = *reinterpret_cast<const bf16x8*>(&Kh[(size_t)((k0) + 32 + sr) * LDKV + sc]); } while (0)
#define AT_SWRITE(b) do { *(bf16x8*)(V_lds + (b) * SHM_V + vst0) = vs0; *(bf16x8*)(V_lds + (b) * SHM_V + vst1) = vs1; const int kc = sc * 2; \
    *(bf16x8*)(K_lds + (b) * SHM_K + AT_KSWZ(sr, kc)) = ks0; *(bf16x8*)(K_lds + (b) * SHM_K + AT_KSWZ(32 + sr, kc)) = ks1; } while (0)
  AT_SLOAD(0); asm volatile("s_waitcnt vmcnt(0)" ::: "memory"); AT_SWRITE(0); __syncthreads();
  const unsigned* selr = MASKED ? sel + (size_t)(rb * QBLK + r32) * 64 : nullptr;
  for (int t = 0; t < NT; ++t) {
    const int buf = t & 1;
    if (t + 1 < NT) AT_SLOAD((t + 1) * KVBLK);
    if (t <= tmax) {
      f32x16 p0, p1; float mn, alpha; bf16x8 pa0, pa1, pa2, pa3;
      unsigned w0 = 0, w1 = 0;
      if (MASKED) { w0 = selr[2 * t] >> (4 * hi); w1 = selr[2 * t + 1] >> (4 * hi); }
      qkt(p0, p1, K_lds + buf * SHM_K, qr, r32, hi);
      if (MASKED) {
#pragma unroll
        for (int r = 0; r < 16; ++r) { const unsigned bit = 1u << ((r & 3) + 8 * (r >> 2)); p0[r] = (w0 & bit) ? p0[r] : -INFINITY; p1[r] = (w1 & bit) ? p1[r] : -INFINITY; }
      }
      partialSM(p0, p1, m_reg, mn, alpha);
      if (__any(alpha < 1.f)) { if (hi == 0) al_l[r32] = alpha; asm volatile("s_waitcnt lgkmcnt(0)" ::: "memory");
#pragma unroll
        for (int d = 0; d < 4; ++d)
#pragma unroll
          for (int r = 0; r < 16; ++r) o[d][r] *= al_l[crow(r, hi)]; }
      finishSM(p0, p1, alpha, l_reg, pa0, pa1, pa2, pa3); AT_SBAR();
      pv_d0(o, vb0 + buf * SHM_V, pa0, pa1, pa2, pa3);
    }
    if (t + 1 < NT) { asm volatile("s_waitcnt vmcnt(0)" ::: "memory"); AT_SWRITE(buf ^ 1); }
    __syncthreads();
  }
  if (hi == 0) li_l[r32] = l_reg; asm volatile("s_waitcnt lgkmcnt(0)" ::: "memory");
  float rli[16];
#pragma unroll
  for (int r = 0; r < 16; ++r) rli[r] = __builtin_amdgcn_rcpf(li_l[crow(r, hi)]);
#pragma unroll
  for (int r = 0; r < 16; ++r) { const int orow = rb * QBLK + crow(r, hi);
#pragma unroll
    for (int d0 = 0; d0 < 4; ++d0) { const float v = o[d0][r] * rli[r];
      if (OUTBF) { Ob[(size_t)orow * ldo + d0 * 32 + r32] = (bf16_t)(cvtpk(v, v) & 0xffffu); } else Of[(size_t)orow * ldo + d0 * 32 + r32] = v; } }
  __syncthreads();
#undef AT_SLOAD
#undef AT_SWRITE
}
#undef AT_KSWZ
#undef AT_SBAR
}
constexpr int NWAVES = 8;
constexpr int RING_OFF = 0, RING_BYTES = 131072;
constexpr int EPI_OFF = RING_BYTES;
constexpr int LDSCTL_OFF = EPI_OFF + 4096;
constexpr int LDS_BYTES = 147456;
constexpr int CW_WQ = 1024;
constexpr int CW_BAR = 4096;
constexpr int MAX_LAUNCHES = 40;
constexpr int NPH = 1 + 9 * DEPTH;


struct Frame {
    LAS unsigned char* lds; int tid, lane, wave, vcu, G;
    unsigned char* ws; const float* x; float* out;
};

__device__ __forceinline__ void frame_refresh(Frame& F) {
    int t = threadIdx.x; asm volatile("" : "+v"(t)); F.tid = t; F.lane = t & 63; F.wave = __builtin_amdgcn_readfirstlane(t >> 6);
}
__device__ __forceinline__ float wave_sum(float v) {
#pragma unroll
    for (int o = 1; o < 64; o <<= 1) v += __shfl_xor(v, o);
    return v;
}
__device__ __forceinline__ void p0_transpose_item(const float* W, int K, int N, int src, int cnt, bf16* WT, int dst_row0, int k0, LAS float* scr, int lane) {
    const int cl = lane & 31; const bool ok = cl < cnt;
#pragma unroll 8
    for (int i = 0; i < 32; ++i) { const int kk = 2 * i + (lane >> 5); scr[kk * 33 + cl] = ok ? W[(size_t)(k0 + kk) * N + src + cl] : 0.f; }
    LDS_WAIT(); asm volatile("" ::: "memory");
    const int c = lane & 7;
#pragma unroll
    for (int j = 0; j < 4; ++j) { const int n = (lane >> 3) + 8 * j; const LAS float* s = scr + (8 * c) * 33 + n;
        v4u o; o.x = pk2(s[0 * 33], s[1 * 33]); o.y = pk2(s[2 * 33], s[3 * 33]); o.z = pk2(s[4 * 33], s[5 * 33]); o.w = pk2(s[6 * 33], s[7 * 33]);
        *(GAS v4u*)(WT + (size_t)(dst_row0 + n) * K + k0 + 8 * c) = o; }
    LDS_WAIT(); asm volatile("" ::: "memory");
}

__device__ __forceinline__ void p0_prologue(Frame& F, const float* const (&in)[17]) {
    LAS float* scr = (LAS float*)(F.lds + RING_OFF + F.wave * 16384);
    const int gw = F.vcu * NWAVES + F.wave, NGW = F.G * NWAVES;
    {
        LAS float* ca = (LAS float*)(F.lds + RING_OFF);
        LAS float* red = (LAS float*)(F.lds + RING_OFF + 32768);
        const float* c = in[I_C];
        for (int i = F.tid; i < BATCH * DM; i += NWAVES * 64) { const float v = c[i]; ca[i] = v / (1.f + __expf(-v)); }
        __syncthreads();
        float* MOD = (float*)(F.ws + WS_MOD);
        for (int u = blockIdx.x; u < DEPTH * 64; u += F.G) {
            const int l = u >> 6, col0 = (u & 63) * 192;
            const float* w = in[I_WMOD] + (size_t)l * DM * 6 * DM + col0 + 4 * F.lane;
            f32x4 a0 = {0, 0, 0, 0}, a1 = a0, a2 = a0, a3 = a0;
            if (F.lane < 48) {
                const int d0 = F.wave * 256;
#pragma unroll 8
                for (int d = d0; d < d0 + 256; ++d) { const f32x4 wv = *(const GAS f32x4*)(w + (size_t)d * 6 * DM); a0 += wv * ca[d]; a1 += wv * ca[DM + d]; a2 += wv * ca[2 * DM + d]; a3 += wv * ca[3 * DM + d]; }
                LAS f32x4* r = (LAS f32x4*)(red + F.wave * 768) + F.lane;
                r[0] = a0; r[48] = a1; r[96] = a2; r[144] = a3;
            }
            __syncthreads();
            for (int i = F.tid; i < 768; i += NWAVES * 64) { float s = 0.f;
#pragma unroll
                for (int wv = 0; wv < 8; ++wv) s += red[wv * 768 + i];
                const int b = i / 192, cc = i % 192; MOD[((size_t)l * BATCH + b) * 6 * DM + col0 + cc] = s + in[I_BMOD][(size_t)l * 6 * DM + col0 + cc]; }
            __syncthreads();
        }
    }
    {
        float* r128 = (float*)(F.ws + WS_ROPE); float* r64 = r128 + SEQ * 64 * 2;
        const int gt = blockIdx.x * (NWAVES * 64) + F.tid, NT = F.G * NWAVES * 64;
        for (int i = gt; i < SEQ * 96; i += NT) {
            const int pos = i / 96, j = i % 96; const bool big = j < 64; const int ii = big ? j : j - 64;
            const float inv = 1.0f / powf(ROPE_THETA, (float)(2 * ii) / (big ? 128.f : 64.f)); const float ang = (float)pos * inv;
            float* o = big ? r128 + ((size_t)pos * 64 + ii) * 2 : r64 + ((size_t)pos * 32 + ii) * 2; o[0] = cosf(ang); o[1] = sinf(ang);
        }
        if (blockIdx.x == 1) {
            float* G = (float*)(F.ws + WS_GAINS);
            for (int i = F.tid; i < DEPTH * 1024; i += NWAVES * 64) { const int l = i >> 10, j = i & 1023;
                G[i] = j < 128 ? in[I_AQN][l * 128 + j] : j < 256 ? in[I_AKN][l * 128 + j - 128] : j < 384 ? in[I_CQN][l * 128 + j - 256] : j < 512 ? in[I_CKN][l * 128 + j - 384] : in[I_BVN][l * 512 + j - 512]; }
        }
        if (blockIdx.x == 2) {
            float* A = (float*)(F.ws + WS_SMALL);
            for (int i = F.tid; i < DEPTH * 256; i += NWAVES * 64) A[i] = in[I_ASUB][i];
            for (int i = F.tid; i < DEPTH * 512; i += NWAVES * 64) A[DEPTH * 256 + i] = in[I_BBIAS][i];
        }
        { bf16* WSB = (bf16*)(F.ws + WS_BWSB); const int gt2 = blockIdx.x * (NWAVES * 64) + F.tid;
          for (int i = gt2; i < DEPTH * 4 * 16384; i += F.G * NWAVES * 64) WSB[i] = (bf16)f2bf(in[I_BWS][i]); }
        if (blockIdx.x == 0 && F.wave < DEPTH) {
            const int l = F.wave; const float* lp = in[I_ALAM] + l * 512;
            const float s1 = wave_sum(lp[F.lane] * lp[128 + F.lane] + lp[64 + F.lane] * lp[192 + F.lane]);
            const float s2 = wave_sum(lp[256 + F.lane] * lp[384 + F.lane] + lp[320 + F.lane] * lp[448 + F.lane]);
            const float li = 0.8f - 0.6f * expf(-0.3f * (float)l);
            if (F.lane == 0) { float* L = (float*)(F.ws + WS_LAM); L[l] = expf(s1) - expf(s2) + li; L[DEPTH + l] = li; }
        }
    }
    {
        constexpr int I_IN = (DM / 64) * (NINP / 32), I_OUT = (DM / 64) * (DM / 32), I_F1 = (DM / 64) * (DFF / 32), I_F2 = (DFF / 64) * (DM / 32), I_L = I_IN + I_OUT + I_F1 + I_F2;
        for (int it = gw; it < DEPTH * I_L; it += NGW) {
            const int l = it / I_L; int r = it % I_L;
            if (r < I_IN) { const int kb = r / (NINP / 32), p32 = r % (NINP / 32); int src, cnt; pg8::in_src_block(p32, src, cnt);
                p0_transpose_item(in[I_WIN] + (size_t)l * DM * NIN, DM, NIN, src, cnt, (bf16*)(F.ws + WS_WIN) + (size_t)l * NINP * DM, p32 * 32, kb * 64, scr, F.lane); continue; } r -= I_IN;
            if (r < I_OUT) { const int kb = r / (DM / 32), nb = r % (DM / 32);
                p0_transpose_item(in[I_WOUT] + (size_t)l * DM * DM, DM, DM, nb * 32, 32, (bf16*)(F.ws + WS_WOUT) + (size_t)l * DM * DM, nb * 32, kb * 64, scr, F.lane); continue; } r -= I_OUT;
            if (r < I_F1) { const int kb = r / (DFF / 32), nb = r % (DFF / 32);
                p0_transpose_item(in[I_WFF1] + (size_t)l * DM * DFF, DM, DFF, nb * 32, 32, (bf16*)(F.ws + WS_WFF1) + (size_t)l * DM * DFF, nb * 32, kb * 64, scr, F.lane); continue; } r -= I_F1;
            { const int kb = r / (DM / 32), nb = r % (DM / 32);
                p0_transpose_item(in[I_WFF2] + (size_t)l * DM * DFF, DFF, DM, nb * 32, 32, (bf16*)(F.ws + WS_WFF2) + (size_t)l * DM * DFF, nb * 32, kb * 64, scr, F.lane); }
        }
    }
}

__device__ __forceinline__ void norm_phase(Frame& F, const float* X, const float* modl, int shi, int sci) {
    const int gw = F.vcu * NWAVES + F.wave, NGW = F.G * NWAVES; bf16* XN = (bf16*)(F.ws + WS_XN);
    for (int m = gw; m < M; m += NGW) {
        const GAS f32x4* xr = (const GAS f32x4*)(X + (size_t)m * DM) + F.lane;
        const float* mb = modl + (size_t)(m / SEQ) * 6 * DM;
        const GAS f32x4* sc = (const GAS f32x4*)(mb + sci * DM) + F.lane; const GAS f32x4* sh = (const GAS f32x4*)(mb + shi * DM) + F.lane;
        f32x4 v[8]; float s = 0.f;
#pragma unroll
        for (int j = 0; j < 8; ++j) { v[j] = xr[64 * j]; s += (v[j].x * v[j].x + v[j].y * v[j].y) + (v[j].z * v[j].z + v[j].w * v[j].w); }
        const float r = rsqrtf(wave_sum(s) * (1.f / DM) + EPS);
        GAS unsigned long long* o8 = (GAS unsigned long long*)(XN + (size_t)m * DM) + F.lane;
#pragma unroll
        for (int j = 0; j < 8; ++j) { const f32x4 a = sc[64 * j], b = sh[64 * j]; const f32x4 y = v[j] * r * (a + 1.f) + b;
            o8[64 * j] = (unsigned long long)pk2(y.x, y.y) | ((unsigned long long)pk2(y.z, y.w) << 32); }
    }
}
__device__ __forceinline__ void combine_phase(Frame& F, int l) {
    const int gw = F.vcu * NWAVES + F.wave, NGW = F.G * NWAVES; bf16* MIX = (bf16*)(F.ws + WS_MIX); const float* OA = (const float*)(F.ws + WS_OA);
    const float* L = (const float*)(F.ws + WS_LAM); const float lam = L[l], omli = 1.f - L[DEPTH + l];
    const f32x4 g = *((const GAS f32x4*)((const float*)(F.ws + WS_SMALL) + l * 256) + F.lane);
    for (int it = gw; it < M * 4; it += NGW) {
        const GAS f32x4* p = (const GAS f32x4*)(OA + (size_t)it * 512) + F.lane;
        const f32x4 o = p[0] - p[64] * lam;
        const float ss = wave_sum((o.x * o.x + o.y * o.y) + (o.z * o.z + o.w * o.w));
        const float r = rsqrtf(ss * (1.f / 256.f) + EPS) * omli;
        const f32x4 y = o * r * g; const int m = it >> 2, h = it & 3;
        *((GAS unsigned long long*)(MIX + (size_t)m * DM + h * 256) + F.lane) = (unsigned long long)pk2(y.x, y.y) | ((unsigned long long)pk2(y.z, y.w) << 32);
    }
}

__device__ __forceinline__ unsigned f2ord(float f) { const unsigned u = __float_as_uint(f); return u ^ ((u >> 31) ? 0xFFFFFFFFu : 0x80000000u); }
__device__ __forceinline__ void index_unit(Frame& F, int u) {
    typedef short bf16x8s __attribute__((ext_vector_type(8)));
    const int b = u >> 7, q0 = (u & 127) * 16, nadm = ((q0 >> 6) + 1) * 64, ntile = nadm >> 4;
    const int lane = F.lane, n16 = lane & 15, kq = lane >> 4;
    const bf16* IQ = (const bf16*)(F.ws + WS_IQ) + (size_t)(b * SEQ + q0) * 512; const bf16* IK = (const bf16*)(F.ws + WS_IK) + (size_t)(b * SEQ) * 64;
    const float* IW = (const float*)(F.ws + WS_IW) + (size_t)(b * SEQ + q0) * 8;
    LAS float* S = (LAS float*)(F.lds + RING_OFF);
    bf16x8s qa[8][2];
#pragma unroll
    for (int ih = 0; ih < 8; ++ih)
#pragma unroll
        for (int kk = 0; kk < 2; ++kk) qa[ih][kk] = *(const bf16x8s*)(IQ + (size_t)n16 * 512 + ih * 64 + kk * 32 + kq * 8);
    float w[4][8];
#pragma unroll
    for (int j = 0; j < 4; ++j) { const f32x4 a = *(const f32x4*)(IW + (4 * kq + j) * 8), c = *(const f32x4*)(IW + (4 * kq + j) * 8 + 4);
        w[j][0] = a.x; w[j][1] = a.y; w[j][2] = a.z; w[j][3] = a.w; w[j][4] = c.x; w[j][5] = c.y; w[j][6] = c.z; w[j][7] = c.w; }
    for (int t = F.wave; t < ntile; t += NWAVES) {
        const bf16* kr = IK + (size_t)(16 * t + n16) * 64 + kq * 8;
        const bf16x8s k0 = *(const bf16x8s*)kr, k1 = *(const bf16x8s*)(kr + 32);
        f32x4 sc = {0.f, 0.f, 0.f, 0.f};
#pragma unroll
        for (int ih = 0; ih < 8; ++ih) {
            f32x4 a = {0.f, 0.f, 0.f, 0.f};
            a = __builtin_amdgcn_mfma_f32_16x16x32_bf16(qa[ih][0], k0, a, 0, 0, 0);
            a = __builtin_amdgcn_mfma_f32_16x16x32_bf16(qa[ih][1], k1, a, 0, 0, 0);
#pragma unroll
            for (int j = 0; j < 4; ++j) sc[j] += fmaxf(a[j], 0.f) * w[j][ih];
        }
#pragma unroll
        for (int j = 0; j < 4; ++j) S[(4 * kq + j) * 2048 + 16 * t + n16] = sc[j];
    }
    LDS_WAIT(); __syncthreads();
    unsigned* SEL = (unsigned*)(F.ws + WS_SEL) + (size_t)(b * SEQ + q0) * 64;
    const int nw = nadm >> 6;
    for (int rr = 0; rr < 2; ++rr) {
        const int row = F.wave * 2 + rr; const LAS float* Sr = S + row * 2048;
        unsigned long long* out = (unsigned long long*)(SEL + (size_t)row * 64);
        if (nadm <= TOPK) { if (lane < nw) out[lane] = ~0ull; continue; }
        unsigned key[32];
#pragma unroll
        for (int i = 0; i < 32; ++i) key[i] = (i < nw) ? f2ord(Sr[64 * i + lane]) : 0u;
        unsigned T = 0u;
        for (int bit = 31; bit >= 0; --bit) {
            const unsigned cand = T | (1u << bit); int cnt = 0;
#pragma unroll
            for (int i = 0; i < 32; ++i) cnt += __popcll(__ballot(key[i] >= cand));
            if (cnt >= TOPK) T = cand;
        }
        int ngt = 0;
#pragma unroll
        for (int i = 0; i < 32; ++i) ngt += __popcll(__ballot(key[i] > T));
        int need = TOPK - ngt;
        const unsigned long long lt = (1ull << lane) - 1ull;
#pragma unroll
        for (int i = 0; i < 32; ++i) {
            const unsigned long long gt = __ballot(key[i] > T), eq = __ballot(key[i] == T);
            unsigned long long take = 0ull;
            if (eq != 0ull && need > 0) { const int pre = __popcll(eq & lt); const bool tk = ((eq >> lane) & 1ull) && pre < need; take = __ballot(tk); need -= __popcll(take); }
            if (i < nw && lane == 0) out[i] = gt | take;
        }
    }
    __syncthreads();
}
__device__ __forceinline__ void gmlp_unit(Frame& F, int u, int l) {
    typedef short bf16x8s __attribute__((ext_vector_type(8)));
    const int blk = u >> 2, g = u & 3, lane = F.lane, n16 = lane & 15, kq = lane >> 4, wv = F.wave;
    const size_t row0 = (size_t)blk * 128;
    const bf16* BV = (const bf16*)(F.ws + WS_BV) + row0 * 512 + g * 128; const bf16* BU = (const bf16*)(F.ws + WS_BU) + row0 * 512 + g * 128;
    bf16* MIX = (bf16*)(F.ws + WS_MIX) + row0 * DM + 1024 + g * 128;
    const bf16* Wg = (const bf16*)(F.ws + WS_BWSB) + ((size_t)l * 4 + g) * 16384; const float* bias = (const float*)(F.ws + WS_SMALL) + DEPTH * 256 + (size_t)l * 512 + g * 128;
    LAS bf16* Vt = (LAS bf16*)(F.lds + RING_OFF);
    for (int i = F.tid; i < 128 * 16; i += NWAVES * 64) { const int j = i >> 4, c8 = (i & 15) * 8; const bf16x8s x = *(const bf16x8s*)(BV + (size_t)j * 512 + c8);
#pragma unroll
        for (int e = 0; e < 8; ++e) Vt[(c8 + e) * 136 + j] = (bf16)x[e]; }
    LDS_WAIT(); __syncthreads();
    const int i0 = 16 * wv, jmax = (wv < 4) ? 64 : 128;
    f32x4 acc[8];
#pragma unroll
    for (int ct = 0; ct < 8; ++ct) acc[ct] = (f32x4){0.f, 0.f, 0.f, 0.f};
    for (int k0 = 0; k0 < jmax; k0 += 32) {
        const bf16x8s a = *(const bf16x8s*)(Wg + (size_t)(i0 + n16) * 128 + k0 + kq * 8);
#pragma unroll
        for (int ct = 0; ct < 8; ++ct) { const bf16x8s bfr = *(const LAS bf16x8s*)(Vt + (ct * 16 + n16) * 136 + k0 + kq * 8);
            acc[ct] = __builtin_amdgcn_mfma_f32_16x16x32_bf16(a, bfr, acc[ct], 0, 0, 0); }
    }
#pragma unroll
    for (int ct = 0; ct < 8; ++ct)
#pragma unroll
        for (int j = 0; j < 4; ++j) { const int i = i0 + 4 * kq + j, c = ct * 16 + n16;
            const float z = acc[ct][j] + bias[i]; const float uu = __uint_as_float(((unsigned)BU[(size_t)i * 512 + c]) << 16);
            MIX[(size_t)i * DM + c] = (bf16)f2bf(uu * z); }
    __syncthreads();
}

struct Args { const float* in[17]; float* out; unsigned char* ws; int ph_lo, ph_hi, li, pad; };
__global__ void __launch_bounds__(NWAVES * 64, 2) mega_fwd(Args args) {
    extern __shared__ __attribute__((aligned(16))) unsigned char lds[];
    Frame F;
    F.lds = (LAS unsigned char*)lds; F.tid = threadIdx.x; F.lane = F.tid & 63; F.wave = __builtin_amdgcn_readfirstlane(F.tid >> 6);
    F.G = gridDim.x; { const int bx = blockIdx.x; F.vcu = (F.G % 8 == 0) ? (bx % 8) * (F.G / 8) + bx / 8 : bx; }
    F.ws = args.ws; F.out = args.out; F.x = args.in[I_X];
    volatile LAS unsigned* LCTL = (volatile LAS unsigned*)(F.lds + LDSCTL_OFF);
    for (int u = F.tid; u < 64; u += NWAVES * 64) LCTL[u] = 0u;
    __syncthreads();
    gu32* ctl = (gu32*)(F.ws + WS_CTL);
    XcdBarrier bar = xcd_barrier_post((unsigned*)(ctl + CW_BAR) + args.li * XCD_BAR_WORDS, LCTL);
    const int lo = args.ph_lo, hi = args.ph_hi;
#ifndef PHMASK
#define PHMASK 0x3ff
#endif
#define EN(b) ((PHMASK >> (b)) & 1)
#define IN(k) (lo <= (k) && (k) < hi)
#define SEAM(k) do { if (IN(k) && IN((k) + 1)) xcd_barrier(bar); } while (0)
    float* MOD = (float*)(F.ws + WS_MOD);

    if (EN(9) && IN(0)) { p0_prologue(F, args.in); } SEAM(0);

    for (int l = 0; l < DEPTH; ++l) {
        const int pb = 1 + 9 * l;
        if (hi <= pb || lo >= pb + 9) continue;
        const float* modl = MOD + (size_t)l * BATCH * 6 * DM;
        const float* Xin = (l == 0) ? F.x : F.out;
        if (EN(0) && IN(pb + 0)) { frame_refresh(F); } if (EN(0) && IN(pb + 0)) norm_phase(F, Xin, modl, 0, 1);
        SEAM(pb + 0);
        if (EN(1) && IN(pb + 1)) { frame_refresh(F); } if (EN(1) && IN(pb + 1)) {
            pg8::Gemm g{(const pg8::bf16_t*)(F.ws + WS_XN), (const pg8::bf16_t*)(F.ws + WS_WIN) + (size_t)l * NINP * DM, M, NINP, DM};
            pg8::StaticOrder S; S.init(M, NINP, F.G, (int)blockIdx.x);
            pg8::EpiIn E{F.ws, l, F.lds};
            pg8::gemm_phase<pg8::EpiIn, pg8::StaticOrder, true, true>(F.lds + RING_OFF, g, S, E);
        }
        SEAM(pb + 1);
        if (EN(2) && IN(pb + 2)) { frame_refresh(F); } if (EN(2) && IN(pb + 2)) {
            for (int i = blockIdx.x; i < 256; i += F.G) { index_unit(F, i); index_unit(F, 511 - i); }
            for (int i = blockIdx.x; i < 256; i += F.G) gmlp_unit(F, i, l);
        }
        SEAM(pb + 2);
        if (EN(3) && IN(pb + 3)) { frame_refresh(F); } if (EN(3) && IN(pb + 3)) {
            const bf16* AQ = (const bf16*)(F.ws + WS_AQ); const bf16* AK = (const bf16*)(F.ws + WS_AK); const bf16* AV = (const bf16*)(F.ws + WS_AV);
            const bf16* CQ = (const bf16*)(F.ws + WS_CQ); const bf16* CK = (const bf16*)(F.ws + WS_CK); const bf16* CV = (const bf16*)(F.ws + WS_CV);
            float* OA = (float*)(F.ws + WS_OA); bf16* MIX = (bf16*)(F.ws + WS_MIX); const unsigned* SEL = (const unsigned*)(F.ws + WS_SEL);
            for (;;) {
                if (F.tid == 0) LCTL[4] = __hip_atomic_fetch_add(ctl + CW_WQ + 64 * l, 1u, RLX_AGENT);
                __syncthreads();
                const int idx = (int)LCTL[4];
                __syncthreads();
                if (idx >= 640) break;
                const int qb = 7 - idx / 80, r = idx % 80;
                if (r < 64) { const int b = r >> 4, h = (r >> 2) & 3, mp = (r >> 1) & 1, vh = r & 1; const size_t rq = (size_t)b * SEQ + 256 * qb, rk = (size_t)b * SEQ;
                    at::attn_unit<1024, 1024, false, false>(AQ + rq * 1024 + h * 256 + mp * 128, AK + rk * 1024 + h * 256 + mp * 128, AV + rk * 1024 + h * 256 + vh * 128, qb, nullptr,
                                                            OA + rq * 2048 + h * 512 + mp * 256 + vh * 128, nullptr, 2048, (char*)lds + RING_OFF); }
                else { const int b = (r - 64) >> 2, h = (r - 64) & 3; const size_t rq = (size_t)b * SEQ + 256 * qb, rk = (size_t)b * SEQ;
                    at::attn_unit<512, 512, true, true>(CQ + rq * 512 + h * 128, CK + rk * 512 + h * 128, CV + rk * 512 + h * 128, qb, SEL + rq * 64,
                                                        nullptr, MIX + rq * DM + 1536 + h * 128, DM, (char*)lds + RING_OFF); }
            }
        }
        SEAM(pb + 3);
        if (EN(4) && IN(pb + 4)) { frame_refresh(F); } if (EN(4) && IN(pb + 4)) combine_phase(F, l);
        SEAM(pb + 4);
        if (EN(5) && IN(pb + 5)) { frame_refresh(F); } if (EN(5) && IN(pb + 5)) {
            pg8::Gemm g{(const pg8::bf16_t*)(F.ws + WS_MIX), (const pg8::bf16_t*)(F.ws + WS_WOUT) + (size_t)l * DM * DM, M, DM, DM};
            pg8::StaticOrder S; S.init(M, DM, F.G, (int)blockIdx.x);
            pg8::EpiRes E{Xin, F.out, modl + 2 * DM};
            pg8::gemm_phase<pg8::EpiRes, pg8::StaticOrder, true, true>(F.lds + RING_OFF, g, S, E);
        }
        SEAM(pb + 5);
        if (EN(6) && IN(pb + 6)) { frame_refresh(F); } if (EN(6) && IN(pb + 6)) norm_phase(F, F.out, modl, 3, 4);
        SEAM(pb + 6);
        if (EN(7) && IN(pb + 7)) { frame_refresh(F); } if (EN(7) && IN(pb + 7)) {
            pg8::Gemm g{(const pg8::bf16_t*)(F.ws + WS_XN), (const pg8::bf16_t*)(F.ws + WS_WFF1) + (size_t)l * DM * DFF, M, DFF, DM};
            pg8::StaticOrder S; S.init(M, DFF, F.G, (int)blockIdx.x);
            pg8::EpiRelu2 E{(bf16*)(F.ws + WS_FF), DFF};
            pg8::gemm_phase<pg8::EpiRelu2, pg8::StaticOrder, true, true>(F.lds + RING_OFF, g, S, E);
        }
        SEAM(pb + 7);
        if (EN(8) && IN(pb + 8)) { frame_refresh(F); } if (EN(8) && IN(pb + 8)) {
            pg8::Gemm g{(const pg8::bf16_t*)(F.ws + WS_FF), (const pg8::bf16_t*)(F.ws + WS_WFF2) + (size_t)l * DM * DFF, M, DM, DFF};
            pg8::StaticOrder S; S.init(M, DM, F.G, (int)blockIdx.x);
            pg8::EpiRes E{F.out, F.out, modl + 5 * DM};
            pg8::gemm_phase<pg8::EpiRes, pg8::StaticOrder, true, true>(F.lds + RING_OFF, g, S, E);
        }
        SEAM(pb + 8);
    }
#undef IN
#undef SEAM
}

static int mega_grid = 0;
static bool mega_setup() {
    if (mega_grid == 0) {
        int dev = 0, cus = 0, per_cu = 0;
        if (hipGetDevice(&dev) != hipSuccess || hipDeviceGetAttribute(&cus, hipDeviceAttributeMultiprocessorCount, dev) != hipSuccess) { fprintf(stderr, "mega: device query failed\n"); mega_grid = -1; return false; }
        if (hipFuncSetAttribute((const void*)mega_fwd, hipFuncAttributeMaxDynamicSharedMemorySize, LDS_BYTES) != hipSuccess) { fprintf(stderr, "mega: hipFuncSetAttribute failed\n"); mega_grid = -1; return false; }
        if (hipOccupancyMaxActiveBlocksPerMultiprocessor(&per_cu, (const void*)mega_fwd, NWAVES * 64, LDS_BYTES) != hipSuccess || per_cu < 1) fprintf(stderr, "mega: occupancy query says %d\n", per_cu);
        (void)hipGetLastError();
        mega_grid = cus;
    }
    return mega_grid > 0;
}
static void mega_launch(void* const* d_in, void* d_out, void* d_ws, hipStream_t stream, int ph_lo, int ph_hi, int li) {
    if (!mega_setup()) return;
    Args a{};
    for (int i = 0; i < 17; ++i) a.in[i] = (const float*)d_in[i];
    a.out = (float*)d_out; a.ws = (unsigned char*)d_ws; a.ph_lo = ph_lo; a.ph_hi = ph_hi; a.li = li; a.pad = 0;
    hipLaunchKernelGGL(mega_fwd, dim3(mega_grid), dim3(NWAVES * 64), LDS_BYTES, stream, a);
    const hipError_t le = hipPeekAtLastError();
    if (le != hipSuccess) fprintf(stderr, "mega: launch failed: %s\n", hipGetErrorName(le));
}
extern "C" void kernel_launch(void* const* d_in, const int* in_sizes, int n_in, void* d_out, int out_size, void* d_ws, size_t ws_size, hipStream_t stream) {
    if (n_in != 17 || out_size != M * DM || ws_size < WS_END) { fprintf(stderr, "kernel_launch: unexpected shapes n_in %d out %d ws %zu (need %zu)\n", n_in, out_size, ws_size, (size_t)WS_END); return; }
    (void)hipMemsetAsync((char*)d_ws + WS_CTL, 0, CTL_ZERO_BYTES, stream);
    mega_launch(d_in, d_out, d_ws, stream, 0, NPH, 0);
}
```

```cpp
#define REPMASK 0
#define IDXREP 0
#include <hip/hip_runtime.h>
#include <cstdio>
#include <cstdint>
#include <cmath>

constexpr int DM = 2048, BATCH = 4, SEQ = 2048, DEPTH = 4, M = BATCH * SEQ, DFF = 4 * DM;
constexpr int CHUNK = 64, TOPK = 256;
constexpr int NIN = 6216, NINP = 6400;
constexpr int OFF_AQ = 0, OFF_AK = 1024, OFF_AV = 2048, OFF_BU = 3072, OFF_BV = 3584, OFF_CQ = 4096, OFF_CK = 4608, OFF_CV = 5120, OFF_IQ = 5632, OFF_IK = 6144, OFF_IW = 6208;
constexpr float EPS = 1e-6f, ROPE_THETA = 10000.0f;
constexpr float QSCALE = 0.08838834764831845f * 1.4426950408889634f;
constexpr float IWSCALE = 0.35355339059327373f * 0.125f;
enum { I_X = 0, I_C, I_WMOD, I_BMOD, I_WIN, I_WOUT, I_AQN, I_AKN, I_ALAM, I_ASUB, I_BVN, I_BWS, I_BBIAS, I_CQN, I_CKN, I_WFF1, I_WFF2 };

constexpr size_t MiB = 1u << 20;
constexpr size_t WS_CTL = 0, CTL_ZERO_BYTES = 1 * MiB;
constexpr size_t WS_MOD = 1 * MiB;
constexpr size_t WS_WIN = 2 * MiB;
constexpr size_t WS_WOUT = WS_WIN + 100 * MiB;
constexpr size_t WS_WFF1 = WS_WOUT + 32 * MiB;
constexpr size_t WS_WFF2 = WS_WFF1 + 128 * MiB;
constexpr size_t WS_XN = WS_WFF2 + 128 * MiB;
constexpr size_t WS_AQ = WS_XN + 32 * MiB, WS_AK = WS_AQ + 16 * MiB, WS_AV = WS_AK + 16 * MiB;
constexpr size_t WS_BU = WS_AV + 16 * MiB, WS_BV = WS_BU + 8 * MiB, WS_CQ = WS_BV + 8 * MiB, WS_CK = WS_CQ + 8 * MiB, WS_CV = WS_CK + 8 * MiB, WS_IQ = WS_CV + 8 * MiB;
constexpr size_t WS_IK = WS_IQ + 8 * MiB;
constexpr size_t WS_IW = WS_IK + 1 * MiB;
constexpr size_t WS_SEL = WS_IW + 1 * MiB;
constexpr size_t WS_MIX = WS_SEL + 2 * MiB;
constexpr size_t WS_OA = WS_MIX + 32 * MiB;
constexpr size_t WS_FF = WS_OA + 64 * MiB;
constexpr size_t WS_ROPE = WS_FF + 128 * MiB;
constexpr int EPI_LDS_OFF = 131072;
constexpr size_t WS_LAM = WS_ROPE + 1536 * 1024;
constexpr size_t WS_GAINS = WS_LAM + 4096;
constexpr size_t WS_SMALL = WS_GAINS + 16384;
constexpr size_t WS_BWSB = WS_ROPE + 2 * MiB;
constexpr size_t WS_PROJ = WS_ROPE + 3 * MiB;
constexpr size_t WS_WINN = WS_PROJ + 200 * MiB;
constexpr size_t WS_END = WS_WINN + 25 * MiB;
#define GAS __attribute__((address_space(1)))
#define LAS __attribute__((address_space(3)))
typedef unsigned short bf16;
typedef unsigned v4u __attribute__((ext_vector_type(4)));
typedef float f32x4 __attribute__((ext_vector_type(4)));
typedef short bf16x8 __attribute__((ext_vector_type(8)));
typedef GAS unsigned gu32;
typedef GAS unsigned long long gu64;
#define RLX_AGENT __ATOMIC_RELAXED, __HIP_MEMORY_SCOPE_AGENT
#define LDS_WAIT() asm volatile("s_waitcnt lgkmcnt(0)" ::: "memory")
#define VM_WAIT() asm volatile("s_waitcnt vmcnt(0)" ::: "memory")
__device__ __forceinline__ unsigned long long rt() { return __builtin_amdgcn_s_memrealtime(); }
__device__ __forceinline__ unsigned f2bf(float f) { unsigned u = __builtin_bit_cast(unsigned, f); return (u + 0x7fffu + ((u >> 16) & 1u)) >> 16; }
__device__ __forceinline__ unsigned pk2(float lo, float hi) { return f2bf(lo) | (f2bf(hi) << 16); }

#define XB_TMO      128
#define XB_XCNT(j)  (256  + 64 * (j))
#define XB_XSUB(j)  (1280 + 64 * (j))
#define XB_XGEN(j)  (2304 + 64 * (j))
#define XB_TOP      3328
#define XB_TOPGEN   3392
#define XCD_BAR_WORDS 3456
#define XB_SPIN_CAP (1u << 18)

__device__ __forceinline__ unsigned xb_ld(unsigned* p)              { return __hip_atomic_load(p, __ATOMIC_RELAXED, __HIP_MEMORY_SCOPE_AGENT); }
__device__ __forceinline__ unsigned xb_add(unsigned* p, unsigned v) { return __hip_atomic_fetch_add(p, v, __ATOMIC_RELAXED, __HIP_MEMORY_SCOPE_AGENT); }
__device__ __forceinline__ unsigned xb_xcc_id() { return (unsigned)__builtin_amdgcn_s_getreg((3 << 11) | 20) & 0xFu; }
#define XB_SPIN(cond, bar) do { unsigned _sp = 0; while (cond) { __builtin_amdgcn_s_sleep(1); \
    if ((++_sp & 255u) == 0u) { if (xb_ld(&(bar)[XB_TMO])) break; if (_sp > XB_SPIN_CAP) { atomicAdd(&(bar)[XB_TMO], 1u); break; } } } } while (0)

struct XcdBarrier {
    unsigned* bar; unsigned x;
    volatile LAS unsigned* st;
};

__device__ __forceinline__ XcdBarrier xcd_barrier_post(unsigned* bar, volatile LAS unsigned* st) {
    XcdBarrier b; b.bar = bar; b.x = xb_xcc_id(); b.st = st;
    if (threadIdx.x == 0) (void)xb_add(&bar[XB_XCNT(b.x)], 1u);
    return b;
}
__device__ __forceinline__ void xcd_barrier_complete(unsigned* bar, unsigned x, unsigned& nloc, unsigned& nx) {
    const unsigned G = gridDim.x * gridDim.y * gridDim.z;
    unsigned sum, cnt, mine, sp = 0u;
    for (;;) {
        sum = 0u; cnt = 0u; mine = 0u;
#pragma unroll
        for (unsigned j = 0; j < 16; ++j) { const unsigned c = xb_ld(&bar[XB_XCNT(j)]); sum += c; cnt += (c > 0u) ? 1u : 0u; mine = (j == x) ? c : mine; }
        if (sum == G) break;
        __builtin_amdgcn_s_sleep(1);
        if ((++sp & 255u) == 0u) { if (xb_ld(&bar[XB_TMO])) break; if (sp > XB_SPIN_CAP) { atomicAdd(&bar[XB_TMO], 1u); break; } }
    }
    nloc = mine > 0u ? mine : 1u; nx = cnt > 0u ? cnt : 1u;
}

__device__ __forceinline__ void xcd_barrier(const XcdBarrier& b) {
    asm volatile("s_waitcnt vmcnt(0)" ::: "memory");
    __syncthreads();
    if (threadIdx.x == 0) {
        unsigned* bar = b.bar;
        __builtin_amdgcn_s_waitcnt(0);
        unsigned nloc = b.st[0], nx = b.st[1];
        if (nloc == 0u) { xcd_barrier_complete(bar, b.x, nloc, nx); b.st[0] = nloc; b.st[1] = nx; }
        const unsigned old = xb_add(&bar[XB_XSUB(b.x)], 1u);
        const unsigned gen = old / nloc;
        if (old + 1u == (gen + 1u) * nloc) {
            __builtin_amdgcn_fence(__ATOMIC_RELEASE, "agent");
            asm volatile("s_waitcnt vmcnt(0)" ::: "memory");
            const unsigned og = xb_add(&bar[XB_TOP], 1u);
            const unsigned tg = og / nx;
            if (og + 1u == (tg + 1u) * nx) xb_add(&bar[XB_TOPGEN], 1u);
            else XB_SPIN(xb_ld(&bar[XB_TOPGEN]) == tg, bar);
            __builtin_amdgcn_fence(__ATOMIC_ACQUIRE, "agent");
            xb_add(&bar[XB_XGEN(b.x)], 1u);
            asm volatile("s_waitcnt vmcnt(0)" ::: "memory");
        } else {
            XB_SPIN(xb_ld(&bar[XB_XGEN(b.x)]) == gen, bar);
            __builtin_amdgcn_fence(__ATOMIC_ACQUIRE, "agent");
            asm volatile("s_waitcnt vmcnt(0)" ::: "memory");
        }
    }
    __syncthreads();
}
namespace pg8 {
#define PG8_LAS __attribute__((address_space(3)))
typedef unsigned short bf16_t;
typedef short bf16x8 __attribute__((ext_vector_type(8)));
typedef float f32x4 __attribute__((ext_vector_type(4)));
typedef unsigned u32x4 __attribute__((ext_vector_type(4)));
constexpr int BM = 256, BK = 64, HALF = 128, HTB = HALF * BK * 2  , STAGE_BYTES = 8 * HTB, NXCD = 8, WGM = 8;

__host__ __device__ __forceinline__ int lds_byte(int r, int c) { const int st = (r >> 4) * 2 + (c >> 5), rr = r & 15, cc = c & 31, ob = rr * 64 + cc * 2; return st * 1024 + (ob ^ (((ob >> 9) & 1) << 5)); }
__host__ __device__ __forceinline__ void stage_rc(int b, int& R, int& C) { const int st = b / 1024, sb = b % 1024, swz = sb ^ (((sb >> 9) & 1) << 5); R = (st >> 1) * 16 + swz / 64; C = (st & 1) * 32 + (swz % 64) / 2; }
__host__ __device__ __forceinline__ int perm32(int rho) { const int n = rho >> 4, i = rho & 15; return 8 * (i >> 2) + 4 * n + (i & 3); }

struct Unit { int pm, pn; };
struct Gemm { const bf16_t* A; const bf16_t* Bt; int M, N, K; };

struct StaticOrder {
    int nM, nN, nwg, G, c;
    __host__ __device__ void init(int M, int N, int G_, int c_) { nM = M / BM; nN = N / BM; nwg = nM * nN; G = G_; c = c_; }
    __host__ __device__ bool next(int i, Unit& u) const {
        const long L = (long)i * G + c; if (L >= nwg) return false;
        int wgid = (int)L; { const int q = nwg / NXCD, r = nwg % NXCD, xcd = wgid % NXCD, off = wgid / NXCD; wgid = (xcd < r ? xcd * (q + 1) : r * (q + 1) + (xcd - r) * q) + off; }
        const int nig = WGM * nN, gid = wgid / nig, fm = gid * WGM, gsz = (nM - fm) < WGM ? (nM - fm) : WGM;
        u.pm = fm + ((wgid % nig) % gsz); u.pn = (wgid % nig) / gsz; return true;
    }
    __device__ __forceinline__ void a_ready(const Unit&) const {}
    __device__ __forceinline__ void done(const Unit&) const {}
};

__device__ __forceinline__ unsigned cvt_pk_bf16(float lo, float hi) { unsigned r; asm volatile("v_cvt_pk_bf16_f32 %0, %1, %2" : "=v"(r) : "v"(lo), "v"(hi)); return r; }
typedef float f32x2 __attribute__((ext_vector_type(2)));
template <class Epi, class Sched, bool ALIGN_EPI = false, bool SP2 = false>
__device__ __forceinline__ void gemm_phase(PG8_LAS unsigned char* lds, const Gemm g, const Sched& S, const Epi& E) {
    int tid_ = threadIdx.x; asm volatile("" : "+v"(tid_));
    const int tid = tid_, wid = __builtin_amdgcn_readfirstlane(tid >> 6), lane = tid & 63, wr = wid >> 2, wc = wid & 3, fr = lane & 15, fq = lane >> 4;
    const int K = g.K, nt = K / BK;
    unsigned voffA[2], voffB[2];
#pragma unroll
    for (int i = 0; i < 2; ++i) { int R, C; stage_rc(tid * 16 + i * 8192, R, C); const int Rb = Epi::PERM ? ((R & ~31) + perm32(R & 31)) : R;
        voffA[i] = (unsigned)(R * K + C) * 2u; voffB[i] = (unsigned)(Rb * K + C) * 2u; }
    const size_t kstep = (size_t)(BK * 2);
    const size_t hstep = (size_t)HALF * K * 2;
    const size_t tstep = 2 * hstep;
    const unsigned ldsw = (unsigned)wid * 1024u;
    const int aoff = lds_byte(wr * 64 + fr, fq * 8), boff = lds_byte(wc * 32 + fr, fq * 8);
#define PG8_SA(b, h) (((b) * 2 + (h)) * HTB)
#define PG8_SB(b, h) ((4 + (b) * 2 + (h)) * HTB)
#define PG8_STAGE(bufoff, gbase, voff) do { _Pragma("unroll") for (int _i = 0; _i < 2; ++_i) \
        __builtin_amdgcn_global_load_lds((const unsigned*)((const char*)(gbase) + (voff)[_i]), (PG8_LAS unsigned*)(lds + (bufoff) + ldsw + _i * 8192), 16, 0, 0); } while (0)
#define PG8_LDA(dst, b, h) do { _Pragma("unroll") for (int m = 0; m < 4; ++m) _Pragma("unroll") for (int k = 0; k < 2; ++k) dst[m][k] = *(const PG8_LAS bf16x8*)(lds + PG8_SA(b, h) + aoff + m * 2048 + k * 1024); } while (0)
#define PG8_LDB(dst, b, h) do { _Pragma("unroll") for (int n = 0; n < 2; ++n) _Pragma("unroll") for (int k = 0; k < 2; ++k) dst[n][k] = *(const PG8_LAS bf16x8*)(lds + PG8_SB(b, h) + boff + n * 2048 + k * 1024); } while (0)
#define PG8_MMA(ai, bj, At, Bt) do { __builtin_amdgcn_s_setprio(1); _Pragma("unroll") for (int m = 0; m < 4; ++m) _Pragma("unroll") for (int n = 0; n < 2; ++n) _Pragma("unroll") for (int k = 0; k < 2; ++k) \
        acc[ai][bj][m][n] = __builtin_amdgcn_mfma_f32_16x16x32_bf16(Bt[n][k], At[m][k], acc[ai][bj][m][n], 0, 0, 0); __builtin_amdgcn_s_setprio(0); } while (0)
#define PG8_WAIT_V(n) asm volatile("s_waitcnt vmcnt(" #n ")" ::: "memory")
#define PG8_WAIT_L(n) asm volatile("s_waitcnt lgkmcnt(" #n ")" ::: "memory")
#define PG8_BAR __builtin_amdgcn_s_barrier()
#define PG8_SCHED __builtin_amdgcn_sched_barrier(0)
    Unit cur, nxt; int ui = 0;
    if (!S.next(0, cur)) return;
    f32x4 acc[2][2][4][2];
#pragma unroll
    for (int a = 0; a < 2; ++a)
#pragma unroll
        for (int b = 0; b < 2; ++b)
#pragma unroll
            for (int m = 0; m < 4; ++m)
#pragma unroll
                for (int n = 0; n < 2; ++n) acc[a][b][m][n] = (f32x4){0.f, 0.f, 0.f, 0.f};
    bf16x8 At[4][2], B0[2][2], B1[2][2];
    const char* cA = (const char*)g.A + (size_t)cur.pm * tstep; const char* cB = (const char*)g.Bt + (size_t)cur.pn * tstep;
    S.a_ready(cur);
    if constexpr (SP2) {
        PG8_STAGE(PG8_SB(0, 0), cB, voffB); PG8_STAGE(PG8_SB(0, 1), cB + hstep, voffB); PG8_STAGE(PG8_SA(0, 0), cA, voffA); PG8_STAGE(PG8_SA(0, 1), cA + hstep, voffA);
        if (wr == 1) PG8_BAR;
        PG8_WAIT_V(2); PG8_BAR;
        PG8_STAGE(PG8_SB(1, 0), cB + kstep, voffB); PG8_STAGE(PG8_SA(1, 0), cA + kstep, voffA); PG8_STAGE(PG8_SB(1, 1), cB + hstep + kstep, voffB);
        PG8_WAIT_V(6); PG8_BAR;
    } else {
        PG8_STAGE(PG8_SB(0, 0), cB, voffB); PG8_STAGE(PG8_SA(0, 0), cA, voffA); PG8_STAGE(PG8_SB(0, 1), cB + hstep, voffB); PG8_STAGE(PG8_SA(0, 1), cA + hstep, voffA);
        if (wr == 1) PG8_BAR;
        PG8_WAIT_V(4); PG8_BAR;
        PG8_STAGE(PG8_SB(1, 0), cB + kstep, voffB); PG8_STAGE(PG8_SA(1, 0), cA + kstep, voffA); PG8_STAGE(PG8_SB(1, 1), cB + hstep + kstep, voffB);
        PG8_WAIT_V(6); PG8_BAR;
    }
    for (;;) {
        const bool has_next = S.next(ui + 1, nxt);
        const char* nA = has_next ? (const char*)g.A + (size_t)nxt.pm * tstep : cA; const char* nB = has_next ? (const char*)g.Bt + (size_t)nxt.pn * tstep : cB;
        for (int t = 0; t < nt; t += 2) {
            const bool last = (t == nt - 2);
            const char* a1 = cA + (size_t)(t + 1) * kstep;
            const char* a2 = last ? nA : cA + (size_t)(t + 2) * kstep; const char* b2 = last ? nB : cB + (size_t)(t + 2) * kstep;
            const char* a3 = a2 + kstep; const char* b3 = b2 + kstep;
            if (last && has_next) S.a_ready(nxt);
            if constexpr (SP2) {
            PG8_LDB(B0, 0, 0); PG8_LDB(B1, 0, 1); PG8_SCHED; PG8_LDA(At, 0, 0); PG8_STAGE(PG8_SA(1, 1), a1 + hstep, voffA);
            PG8_WAIT_V(8); PG8_WAIT_L(0); PG8_BAR; PG8_MMA(0, 0, At, B0); PG8_MMA(0, 1, At, B1); PG8_BAR; PG8_SCHED;
            PG8_LDA(At, 0, 1); PG8_STAGE(PG8_SB(0, 0), b2, voffB); PG8_STAGE(PG8_SB(0, 1), b2 + hstep, voffB); PG8_STAGE(PG8_SA(0, 0), a2, voffA);
            PG8_WAIT_V(8); PG8_WAIT_L(0); PG8_BAR; PG8_MMA(1, 0, At, B0); PG8_MMA(1, 1, At, B1); PG8_BAR; PG8_SCHED;
            PG8_LDB(B0, 1, 0); PG8_LDB(B1, 1, 1); PG8_SCHED; PG8_LDA(At, 1, 0); PG8_STAGE(PG8_SA(0, 1), a2 + hstep, voffA);
            PG8_WAIT_V(8); PG8_WAIT_L(0); PG8_BAR; PG8_MMA(0, 0, At, B0); PG8_MMA(0, 1, At, B1); PG8_BAR; PG8_SCHED;
            PG8_LDA(At, 1, 1); PG8_STAGE(PG8_SB(1, 0), b3, voffB); PG8_STAGE(PG8_SB(1, 1), b3 + hstep, voffB); PG8_STAGE(PG8_SA(1, 0), a3, voffA);
            PG8_WAIT_V(8); PG8_WAIT_L(0); PG8_BAR; PG8_MMA(1, 0, At, B0); PG8_MMA(1, 1, At, B1); PG8_BAR; PG8_SCHED;
            } else {
            PG8_LDB(B0, 0, 0); PG8_SCHED; PG8_LDA(At, 0, 0); PG8_STAGE(PG8_SA(1, 1), a1 + hstep, voffA);
            PG8_WAIT_L(8); PG8_BAR; PG8_WAIT_L(0); PG8_MMA(0, 0, At, B0); PG8_BAR; PG8_SCHED;
            PG8_LDB(B1, 0, 1); PG8_STAGE(PG8_SB(0, 0), b2, voffB);
            PG8_BAR; PG8_WAIT_L(0); PG8_MMA(0, 1, At, B1); PG8_BAR;
            PG8_LDA(At, 0, 1); PG8_STAGE(PG8_SA(0, 0), a2, voffA);
            PG8_BAR; PG8_WAIT_L(0); PG8_MMA(1, 0, At, B0); PG8_BAR; PG8_SCHED;
            PG8_STAGE(PG8_SB(0, 1), b2 + hstep, voffB);
            PG8_WAIT_V(6); PG8_BAR; PG8_MMA(1, 1, At, B1); PG8_BAR;
            PG8_LDB(B0, 1, 0); PG8_SCHED; PG8_LDA(At, 1, 0); PG8_STAGE(PG8_SA(0, 1), a2 + hstep, voffA);
            PG8_WAIT_L(8); PG8_BAR; PG8_WAIT_L(0); PG8_MMA(0, 0, At, B0); PG8_BAR; PG8_SCHED;
            PG8_LDB(B1, 1, 1); PG8_STAGE(PG8_SB(1, 0), b3, voffB);
            PG8_BAR; PG8_WAIT_L(0); PG8_MMA(0, 1, At, B1); PG8_BAR;
            PG8_LDA(At, 1, 1); PG8_STAGE(PG8_SA(1, 0), a3, voffA);
            PG8_BAR; PG8_WAIT_L(0); PG8_MMA(1, 0, At, B0); PG8_BAR; PG8_SCHED;
            PG8_STAGE(PG8_SB(1, 1), b3 + hstep, voffB);
            PG8_WAIT_V(6); PG8_BAR; PG8_MMA(1, 1, At, B1); PG8_BAR;
            }
        }
        if constexpr (ALIGN_EPI) { if (wr == 0) PG8_BAR; }
        if constexpr (!Epi::AFTER_DRAIN) { E(acc, cur, wr, wc, fr, fq); S.done(cur); }
        if (!has_next) break;
#pragma unroll
        for (int a = 0; a < 2; ++a)
#pragma unroll
            for (int b = 0; b < 2; ++b)
#pragma unroll
                for (int m = 0; m < 4; ++m)
#pragma unroll
                    for (int n = 0; n < 2; ++n) acc[a][b][m][n] = (f32x4){0.f, 0.f, 0.f, 0.f};
        cur = nxt; cA = nA; cB = nB; ++ui;
        if constexpr (ALIGN_EPI) { if (wr == 1) PG8_BAR; }
    }
    PG8_WAIT_V(0);
    if constexpr (!ALIGN_EPI) { if (wr == 0) PG8_BAR; }
    PG8_BAR;
    if constexpr (Epi::AFTER_DRAIN) { E.fused(acc, cur, wr, wc, fr, fq, lds, wid, lane); S.done(cur); }
#undef PG8_SA
#undef PG8_SB
#undef PG8_STAGE
#undef PG8_LDA
#undef PG8_LDB
#undef PG8_MMA
#undef PG8_WAIT_V
#undef PG8_WAIT_L
#undef PG8_BAR
#undef PG8_SCHED
}
}
namespace pg8 {
typedef float f32x2 __attribute__((ext_vector_type(2)));
__device__ __forceinline__ float gelu_tanh_fast(float x) {
    const float u = x * (0.7978845608028654f + 0.035677408136300125f * x * x);
    const float e = __builtin_amdgcn_exp2f(-2.8853900817779268f * u);
    return x * __builtin_amdgcn_rcpf(1.0f + e);
}
__device__ __forceinline__ u32x4 pack8(const f32x4& a, const f32x4& b) { u32x4 w; w.x = cvt_pk_bf16(a[0], a[1]); w.y = cvt_pk_bf16(a[2], a[3]); w.z = cvt_pk_bf16(b[0], b[1]); w.w = cvt_pk_bf16(b[2], b[3]); return w; }

struct EpiIn {
    static constexpr bool PERM = true, AFTER_DRAIN = false;
    unsigned char* ws; int l; PG8_LAS unsigned char* ldsb;
    __device__ __forceinline__ void operator()(f32x4 (&acc)[2][2][4][2], const Unit& u, int wr, int wc, int fr, int fq) const {
        bf16_t* const AQ = (bf16_t*)(ws + WS_AQ); bf16_t* const AK = (bf16_t*)(ws + WS_AK); bf16_t* const AV = (bf16_t*)(ws + WS_AV); bf16_t* const BU = (bf16_t*)(ws + WS_BU); bf16_t* const BV = (bf16_t*)(ws + WS_BV);
        bf16_t* const CQ = (bf16_t*)(ws + WS_CQ); bf16_t* const CK = (bf16_t*)(ws + WS_CK); bf16_t* const CV = (bf16_t*)(ws + WS_CV); bf16_t* const IQ = (bf16_t*)(ws + WS_IQ); bf16_t* const IK = (bf16_t*)(ws + WS_IK);
        float* const IW = (float*)(ws + WS_IW);
        const float* const gl = (const float*)(ws + WS_GAINS) + l * 1024;
        const float* const aqn = gl; const float* const akn = gl + 128; const float* const cqn = gl + 256; const float* const ckn = gl + 384; const float* const bvn = gl + 512;
        const float* const rope128 = (const float*)(ws + WS_ROPE); const float* const rope64 = rope128 + SEQ * 64 * 2;
        PG8_LAS float* const P = (PG8_LAS float*)(ldsb + EPI_LDS_OFF);
        const int pn = u.pn, row0 = u.pm * BM + wr * 64 + fr;
        const bool qk = (pn < 8) || (pn >= 16 && pn < 20), bv = (pn == 14 || pn == 15);
        if (qk || bv) {
            if (bv) {
#pragma unroll
                for (int ai = 0; ai < 2; ++ai)
#pragma unroll
                    for (int bj = 0; bj < 2; ++bj)
#pragma unroll
                        for (int m = 0; m < 4; ++m)
#pragma unroll
                            for (int n = 0; n < 2; ++n)
#pragma unroll
                                for (int e = 0; e < 4; ++e) acc[ai][bj][m][n][e] = gelu_tanh_fast(acc[ai][bj][m][n][e]);
            }
#pragma unroll
            for (int ai = 0; ai < 2; ++ai)
#pragma unroll
                for (int m = 0; m < 4; ++m) {
                    float s = 0.f;
#pragma unroll
                    for (int bj = 0; bj < 2; ++bj)
#pragma unroll
                        for (int n = 0; n < 2; ++n) { const f32x4 x = acc[ai][bj][m][n]; s += (x[0] * x[0] + x[1] * x[1]) + (x[2] * x[2] + x[3] * x[3]); }
                    s += __shfl_xor(s, 16); s += __shfl_xor(s, 32);
                    if (fq == 0) P[(ai * HALF + wr * 64 + m * 16 + fr) * 4 + wc] = s;
                }
            asm volatile("s_waitcnt lgkmcnt(0)" ::: "memory"); __builtin_amdgcn_s_barrier(); asm volatile("" ::: "memory");
            const int hv = wc >> 1, d0b = 32 * (wc & 1) + 8 * fq;
            const float* gain; bf16_t* dst; int pitch, tl; float qs = 1.f;
            if (pn < 4) { gain = aqn; dst = AQ; pitch = 1024; tl = pn; qs = QSCALE; }
            else if (pn < 8) { gain = akn; dst = AK; pitch = 1024; tl = pn - 4; }
            else if (pn < 16) { gain = bvn + (pn - 14) * 256 + hv * 128; dst = BV; pitch = 512; tl = pn - 14; }
            else if (pn < 18) { gain = cqn; dst = CQ; pitch = 512; tl = pn - 16; qs = QSCALE; }
            else { gain = ckn; dst = CK; pitch = 512; tl = pn - 18; }
            const f32x4 g00 = *(const f32x4*)(gain + d0b), g01 = *(const f32x4*)(gain + d0b + 4), g10 = *(const f32x4*)(gain + 64 + d0b), g11 = *(const f32x4*)(gain + 64 + d0b + 4);
            const int colb = tl * 256 + hv * 128 + d0b;
            const f32x4* rp0 = (const f32x4*)(rope128 + ((size_t)(row0 & (SEQ - 1)) * 64 + d0b) * 2);
            f32x4 nc0, nc1, nc2, nc3;
            if (!bv) { nc0 = rp0[0]; nc1 = rp0[1]; nc2 = rp0[2]; nc3 = rp0[3]; }
#pragma unroll
            for (int ai = 0; ai < 2; ++ai)
#pragma unroll
                for (int m = 0; m < 4; ++m) {
                    const int rl = ai * HALF + wr * 64 + m * 16 + fr, row = row0 + ai * HALF + m * 16;
                    const f32x4 c0 = nc0, c1 = nc1, c2 = nc2, c3 = nc3;
                    if (!bv && (ai * 4 + m) < 7) { const int nx = (ai * 4 + m + 1); const f32x4* rp = rp0 + (size_t)((nx >> 2) * HALF + (nx & 3) * 16) * 32; nc0 = rp[0]; nc1 = rp[1]; nc2 = rp[2]; nc3 = rp[3]; }
                    const float tot = P[rl * 4 + wc] + P[rl * 4 + (wc ^ 1)];
                    const float rs = __builtin_amdgcn_rsqf(tot * (1.f / 128.f) + EPS);
                    f32x4 x00 = acc[ai][0][m][0] * rs * g00, x01 = acc[ai][0][m][1] * rs * g01, x10 = acc[ai][1][m][0] * rs * g10, x11 = acc[ai][1][m][1] * rs * g11;
                    bf16_t* o = dst + (size_t)row * pitch + colb;
                    if (!bv) {
                        const f32x4 cs0 = {c0[0], c0[2], c1[0], c1[2]}, sn0 = {c0[1], c0[3], c1[1], c1[3]}, cs1 = {c2[0], c2[2], c3[0], c3[2]}, sn1 = {c2[1], c2[3], c3[1], c3[3]};
                        const f32x4 y00 = (x00 * cs0 - x10 * sn0) * qs, y10 = (x10 * cs0 + x00 * sn0) * qs, y01 = (x01 * cs1 - x11 * sn1) * qs, y11 = (x11 * cs1 + x01 * sn1) * qs;
                        x00 = y00; x10 = y10; x01 = y01; x11 = y11;
                    }
                    *(u32x4*)o = pack8(x00, x01); *(u32x4*)(o + 64) = pack8(x10, x11);
                    asm volatile("" : "+v"(nc0), "+v"(nc1), "+v"(nc2), "+v"(nc3) :: "memory");
                }
        } else if (pn == 22 || pn == 23 || pn == 24) {
            if (pn < 24 || wc == 0) {
                bf16_t* dst = pn < 24 ? IQ : IK; const int pitch = pn < 24 ? 512 : 64, colb = (pn < 24 ? (pn - 22) * 256 + wc * 64 : 0) + 8 * fq;
                const f32x4* rp0 = (const f32x4*)(rope64 + ((size_t)(row0 & (SEQ - 1)) * 32 + 8 * fq) * 2);
                f32x4 nc0 = rp0[0], nc1 = rp0[1], nc2 = rp0[2], nc3 = rp0[3];
#pragma unroll
                for (int ai = 0; ai < 2; ++ai)
#pragma unroll
                    for (int m = 0; m < 4; ++m) {
                        const int row = row0 + ai * HALF + m * 16;
                        const f32x4 c0 = nc0, c1 = nc1, c2 = nc2, c3 = nc3;
                        if ((ai * 4 + m) < 7) { const int nx = (ai * 4 + m + 1); const f32x4* rp = rp0 + (size_t)((nx >> 2) * HALF + (nx & 3) * 16) * 16; nc0 = rp[0]; nc1 = rp[1]; nc2 = rp[2]; nc3 = rp[3]; }
                        const f32x4 cs0 = {c0[0], c0[2], c1[0], c1[2]}, sn0 = {c0[1], c0[3], c1[1], c1[3]}, cs1 = {c2[0], c2[2], c3[0], c3[2]}, sn1 = {c2[1], c2[3], c3[1], c3[3]};
                        const f32x4 x00 = acc[ai][0][m][0], x01 = acc[ai][0][m][1], x10 = acc[ai][1][m][0], x11 = acc[ai][1][m][1];
                        const f32x4 y00 = x00 * cs0 - x10 * sn0, y10 = x10 * cs0 + x00 * sn0, y01 = x01 * cs1 - x11 * sn1, y11 = x11 * cs1 + x01 * sn1;
                        bf16_t* o = dst + (size_t)row * pitch + colb;
                        *(u32x4*)o = pack8(y00, y01); *(u32x4*)(o + 32) = pack8(y10, y11);
                        asm volatile("" : "+v"(nc0), "+v"(nc1), "+v"(nc2), "+v"(nc3) :: "memory");
                    }
            } else if (wc == 1 && fq == 0) {
#pragma unroll
                for (int ai = 0; ai < 2; ++ai)
#pragma unroll
                    for (int m = 0; m < 4; ++m) { float* o = IW + (size_t)(row0 + ai * HALF + m * 16) * 8; *(f32x4*)o = acc[ai][0][m][0] * IWSCALE; *(f32x4*)(o + 4) = acc[ai][0][m][1] * IWSCALE; }
            }
        } else {
            bf16_t* dst; int pitch, tl; const bool g = (pn == 12 || pn == 13);
            if (pn < 12) { dst = AV; pitch = 1024; tl = pn - 8; } else if (pn < 14) { dst = BU; pitch = 512; tl = pn - 12; } else { dst = CV; pitch = 512; tl = pn - 20; }
            const int colb = tl * 256 + wc * 32 + 8 * fq;
#pragma unroll
            for (int ai = 0; ai < 2; ++ai)
#pragma unroll
                for (int m = 0; m < 4; ++m) { bf16_t* o = dst + (size_t)(row0 + ai * HALF + m * 16) * pitch + colb;
#pragma unroll
                    for (int bj = 0; bj < 2; ++bj) { f32x4 v0 = acc[ai][bj][m][0], v1 = acc[ai][bj][m][1];
                        if (g) {
#pragma unroll
                            for (int e = 0; e < 4; ++e) { v0[e] = gelu_tanh_fast(v0[e]); v1[e] = gelu_tanh_fast(v1[e]); } }
                        *(u32x4*)(o + bj * HALF) = pack8(v0, v1); } }
        }
    }
};
__host__ __device__ __forceinline__ void in_src_block(int p32, int& src, int& cnt) {
    const int pn = p32 >> 3, pb = p32 & 7, bj = pb >> 2, wc = pb & 3; cnt = 32;
    if (pn < 8 || (pn >= 14 && pn < 20)) src = pn * 256 + (4 * (wc >> 1) + 2 * bj + (wc & 1)) * 32;
    else if (pn == 22 || pn == 23) src = pn * 256 + (2 * wc + bj) * 32;
    else if (pn == 24) { if (pb == 0) src = OFF_IK; else if (pb == 4) src = OFF_IK + 32; else if (pb == 1) { src = OFF_IW; cnt = 8; } else { src = 0; cnt = 0; } }
    else src = pn * 256 + pb * 32;
}

struct InOrder {
    StaticOrder so;
    __host__ __device__ void init(int G_, int c_) { so.init(32 * BM, 24 * BM, G_, c_); }
    __host__ __device__ bool next(int i, Unit& u) const {
        if (!so.next(i, u)) return false;
        const int r = u.pm & 7;
        if (r < 2) { if (u.pn < 3) { u.pm = (u.pm & ~7) + 2 + 3 * r + u.pn; u.pn = 24; } else if (u.pn == 3) u.pn = 24; }
        return true;
    }
    __device__ __forceinline__ void a_ready(const Unit&) const {}
    __device__ __forceinline__ void done(const Unit&) const {}
};
struct OneUnit {
    int pm, pn;
    __host__ __device__ bool next(int i, Unit& u) const { if (i != 0) return false; u.pm = pm; u.pn = pn; return true; }
    __device__ __forceinline__ void a_ready(const Unit&) const {}
    __device__ __forceinline__ void done(const Unit&) const {}
};
struct EpiRes {
    static constexpr bool PERM = false, AFTER_DRAIN = false;
    const float* base; float* out; const float* gate;
    __device__ __forceinline__ void operator()(f32x4 (&acc)[2][2][4][2], const Unit& u, int wr, int wc, int fr, int fq) const {
        const int row0 = u.pm * BM + wr * 64 + fr, col0 = u.pn * BM + wc * 32 + 4 * fq;
        const float* g = gate + (size_t)((u.pm * BM) / SEQ) * 6 * DM + col0;
        f32x4 gv[2][2];
#pragma unroll
        for (int bj = 0; bj < 2; ++bj)
#pragma unroll
            for (int n = 0; n < 2; ++n) gv[bj][n] = *(const f32x4*)(g + bj * HALF + n * 16);
#pragma unroll
        for (int ai = 0; ai < 2; ++ai)
#pragma unroll
            for (int m = 0; m < 4; ++m) { const size_t off = (size_t)(row0 + ai * HALF + m * 16) * DM + col0;
#pragma unroll
                for (int bj = 0; bj < 2; ++bj)
#pragma unroll
                    for (int n = 0; n < 2; ++n) { const f32x4 b = *(const f32x4*)(base + off + bj * HALF + n * 16); *(f32x4*)(out + off + bj * HALF + n * 16) = b + gv[bj][n] * acc[ai][bj][m][n]; } }
    }
};
struct EpiRelu2 {
    static constexpr bool PERM = true, AFTER_DRAIN = false;
    bf16_t* O; int ldc;
    __device__ __forceinline__ void operator()(f32x4 (&acc)[2][2][4][2], const Unit& u, int wr, int wc, int fr, int fq) const {
        const int row0 = u.pm * BM + wr * 64 + fr, col0 = u.pn * BM + wc * 32 + 8 * fq;
#pragma unroll
        for (int ai = 0; ai < 2; ++ai)
#pragma unroll
            for (int m = 0; m < 4; ++m) { bf16_t* o = O + (size_t)(row0 + ai * HALF + m * 16) * ldc + col0;
#pragma unroll
                for (int bj = 0; bj < 2; ++bj) { f32x4 v0 = acc[ai][bj][m][0], v1 = acc[ai][bj][m][1];
#pragma unroll
                    for (int e = 0; e < 4; ++e) { const float a = fmaxf(v0[e], 0.f), b = fmaxf(v1[e], 0.f); v0[e] = a * a; v1[e] = b * b; }
                    *(u32x4*)(o + bj * HALF) = pack8(v0, v1); } }
    }
};
}
namespace at {
using bf16x8 = __attribute__((ext_vector_type(8))) short;
using s16x4  = __attribute__((ext_vector_type(4))) short;
using f32x16 = __attribute__((ext_vector_type(16))) float;
using u32x4  = __attribute__((ext_vector_type(4))) unsigned;
typedef unsigned short bf16_t;
constexpr int D = 128, NW = 8, QBLK = 32, KVBLK = 64;
constexpr int SHM_V = KVBLK * D * 2, SHM_K = KVBLK * D * 2, SHM_ATTN = 2 * SHM_V + 2 * SHM_K + NW * 64 * 4;
constexpr float THR_L2 = 8.f;
#define AT_KSWZ(row, colB) ((row) * 256 + ((colB) ^ (((row) & 7) << 4)))
#define AT_SBAR() __builtin_amdgcn_sched_barrier(0)
__device__ __forceinline__ int crow(int r, int hi) { return (r & 3) + 8 * (r >> 2) + 4 * hi; }
__device__ __forceinline__ unsigned cvtpk(float lo, float hi) { unsigned r; asm volatile("v_cvt_pk_bf16_f32 %0, %1, %2" : "=v"(r) : "v"(lo), "v"(hi)); return r; }

__device__ __forceinline__ void partialSM(f32x16& p0, f32x16& p1, float& m_reg, float& mn, float& alpha) {
  float pmax = p0[0];
#pragma unroll
  for (int r = 1; r < 16; ++r) pmax = fmaxf(pmax, p0[r]);
#pragma unroll
  for (int r = 0; r < 16; ++r) pmax = fmaxf(pmax, p1[r]);
  { auto rr = __builtin_amdgcn_permlane32_swap(__float_as_uint(pmax), __float_as_uint(pmax), false, false);
    pmax = fmaxf(__uint_as_float(rr[0]), __uint_as_float(rr[1])); }
  if (__builtin_expect(__all(pmax - m_reg <= THR_L2), 1)) { mn = m_reg; alpha = 1.f; }
  else { mn = fmaxf(m_reg, pmax); alpha = __builtin_amdgcn_exp2f(m_reg - mn); m_reg = mn; }
#pragma unroll
  for (int r = 0; r < 16; ++r) p0[r] = __builtin_amdgcn_exp2f(p0[r] - mn);
#pragma unroll
  for (int r = 0; r < 16; ++r) p1[r] = p1[r] - mn;
}
__device__ __forceinline__ void finishSM(f32x16& p0, f32x16& p1, float alpha, float& l_reg, bf16x8& pa0, bf16x8& pa1, bf16x8& pa2, bf16x8& pa3) {
#pragma unroll
  for (int r = 0; r < 16; ++r) p1[r] = __builtin_amdgcn_exp2f(p1[r]);
  float ps = 0;
#pragma unroll
  for (int r = 0; r < 16; ++r) ps += p0[r];
#pragma unroll
  for (int r = 0; r < 16; ++r) ps += p1[r];
  { auto rr = __builtin_amdgcn_permlane32_swap(__float_as_uint(ps), __float_as_uint(ps), false, false);
    ps = __uint_as_float(rr[0]) + __uint_as_float(rr[1]); }
  l_reg = l_reg * alpha + ps;
#define AT_PK4(P, BASE, OUT) do { unsigned a0 = cvtpk(P[BASE + 0], P[BASE + 1]), a1 = cvtpk(P[BASE + 2], P[BASE + 3]);   \
    unsigned b0 = cvtpk(P[BASE + 4], P[BASE + 5]), b1 = cvtpk(P[BASE + 6], P[BASE + 7]);                              \
    auto r0 = __builtin_amdgcn_permlane32_swap(a0, b0, false, false); auto r1 = __builtin_amdgcn_permlane32_swap(a1, b1, false, false); \
    u32x4 w = {r0[0], r1[0], r0[1], r1[1]}; OUT = *reinterpret_cast<bf16x8*>(&w); } while (0)
  AT_PK4(p0, 0, pa0); AT_PK4(p0, 8, pa1); AT_PK4(p1, 0, pa2); AT_PK4(p1, 8, pa3);
#undef AT_PK4
}
__device__ __forceinline__ void qkt(f32x16& p0, f32x16& p1, const char* Ks, const bf16x8* qr, int r32, int hi) {
  p0 = f32x16{}; p1 = f32x16{};
#pragma unroll
  for (int d0 = 0; d0 < 8; ++d0) { const int cb = (d0 * 16 + hi * 8) * 2;
    bf16x8 b0 = *reinterpret_cast<const bf16x8*>(Ks + AT_KSWZ(r32, cb));
    bf16x8 b1 = *reinterpret_cast<const bf16x8*>(Ks + AT_KSWZ(32 + r32, cb));
    p0 = __builtin_amdgcn_mfma_f32_32x32x16_bf16(b0, qr[d0], p0, 0, 0, 0);
    p1 = __builtin_amdgcn_mfma_f32_32x32x16_bf16(b1, qr[d0], p1, 0, 0, 0); }
}
__device__ __forceinline__ int v_st(int k, int c) { const int kk = (k & ~0xC) | ((k & 4) << 1) | ((k & 8) >> 1); return ((kk >> 3) * 4 + (c >> 5)) * 512 + ((kk & 7) * 32 + (c & 31)) * 2; }
__device__ __forceinline__ int v_rd_base(int lane) { return ((lane & 3) << 3) | (((lane >> 2) & 3) << 6) | (((lane >> 4) & 1) << 5) | (((lane >> 5) & 1) << 8); }
constexpr int v_rd_off(int d0, int ks, int half) { return d0 * 512 + ks * 4096 + half * 2048; }
template <int OFF> __device__ __forceinline__ s16x4 tr_read(int vb) { s16x4 r; asm volatile("ds_read_b64_tr_b16 %0, %1 offset:%2" : "=&v"(r) : "v"(vb), "i"(OFF) : "memory"); return r; }
template <int D0> __device__ __forceinline__ void pv_one(f32x16& od, int vb, bf16x8 pa0, bf16x8 pa1, bf16x8 pa2, bf16x8 pa3) {
  const s16x4 l0 = tr_read<v_rd_off(D0, 0, 0)>(vb), h0 = tr_read<v_rd_off(D0, 0, 1)>(vb), l1 = tr_read<v_rd_off(D0, 1, 0)>(vb), h1 = tr_read<v_rd_off(D0, 1, 1)>(vb);
  const s16x4 l2 = tr_read<v_rd_off(D0, 2, 0)>(vb), h2 = tr_read<v_rd_off(D0, 2, 1)>(vb), l3 = tr_read<v_rd_off(D0, 3, 0)>(vb), h3 = tr_read<v_rd_off(D0, 3, 1)>(vb);
  asm volatile("s_waitcnt lgkmcnt(0)" ::: "memory"); AT_SBAR();
#define AT_PK(L, H) (bf16x8){L[0], L[1], L[2], L[3], H[0], H[1], H[2], H[3]}
  od = __builtin_amdgcn_mfma_f32_32x32x16_bf16(pa0, AT_PK(l0, h0), od, 0, 0, 0);
  od = __builtin_amdgcn_mfma_f32_32x32x16_bf16(pa1, AT_PK(l1, h1), od, 0, 0, 0);
  od = __builtin_amdgcn_mfma_f32_32x32x16_bf16(pa2, AT_PK(l2, h2), od, 0, 0, 0);
  od = __builtin_amdgcn_mfma_f32_32x32x16_bf16(pa3, AT_PK(l3, h3), od, 0, 0, 0);
#undef AT_PK
}
__device__ __forceinline__ void pv_d0(f32x16* o, int vb, bf16x8 pa0, bf16x8 pa1, bf16x8 pa2, bf16x8 pa3) {
  pv_one<0>(o[0], vb, pa0, pa1, pa2, pa3); pv_one<1>(o[1], vb, pa0, pa1, pa2, pa3); pv_one<2>(o[2], vb, pa0, pa1, pa2, pa3); pv_one<3>(o[3], vb, pa0, pa1, pa2, pa3);
}

template <int LDQ, int LDKV, bool MASKED, bool OUTBF>
__device__ __forceinline__ void attn_unit(const bf16_t* __restrict__ Qb, const bf16_t* __restrict__ Kh, const bf16_t* __restrict__ Vh, int qb, const unsigned* __restrict__ sel,
                                          float* __restrict__ Of, bf16_t* __restrict__ Ob, int ldo, char* lds) {
  int tid_ = threadIdx.x; asm volatile("" : "+v"(tid_));
  const int tid = tid_, wid = __builtin_amdgcn_readfirstlane(tid >> 6), lane = tid & 63, r32 = lane & 31, hi = lane >> 5;
  const int rb = wid < 4 ? wid : 11 - wid;
  const int NT = 4 * qb + 4, tmax = 4 * qb + (rb >> 1);
  char* V_lds = lds; char* K_lds = lds + 2 * SHM_V;
  float* ws = (float*)(lds + 2 * SHM_V + 2 * SHM_K) + wid * 64; float* li_l = ws; float* al_l = ws + 32;
  float m_reg = -1e30f, l_reg = 0; f32x16 o[4] = {}; bf16x8 qr[8];
  const bf16_t* Qw = Qb + (size_t)(rb * QBLK + r32) * LDQ + hi * 8;
#pragma unroll
  for (int d0 = 0; d0 < 8; ++d0) qr[d0] = *reinterpret_cast<const bf16x8*>(Qw + d0 * 16);
  const int sr = tid >> 4, sc = (tid & 15) * 8, vst0 = v_st(sr, sc), vst1 = v_st(32 + sr, sc);
  const int vb0 = (int)(uintptr_t)V_lds + v_rd_base(lane);
  struct { bf16x8 vs0, vs1, ks0, ks1; } sr_[1];
#define AT_SLOAD(i, k0) do { sr_[i].vs0 = *reinterpret_cast<const bf16x8*>(&Vh[(size_t)((k0) + sr) * LDKV + sc]); sr_[i].vs1 = *reinterpret_cast<const bf16x8*>(&Vh[(size_t)((k0) + 32 + sr) * LDKV + sc]); \
    sr_[i].ks0 = *reinterpret_cast<const bf16x8*>(&Kh[(size_t)((k0) + sr) * LDKV + sc]); sr_[i].ks1 = *reinterpret_cast<const bf16x8*>(&Kh[(size_t)((k0) + 32 + sr) * LDKV + sc]); } while (0)
#define AT_SWRITE(b, i) do { *(bf16x8*)(V_lds + (b) * SHM_V + vst0) = sr_[i].vs0; *(bf16x8*)(V_lds + (b) * SHM_V + vst1) = sr_[i].vs1; const int kc = sc * 2; \
    *(bf16x8*)(K_lds + (b) * SHM_K + AT_KSWZ(sr, kc)) = sr_[i].ks0; *(bf16x8*)(K_lds + (b) * SHM_K + AT_KSWZ(32 + sr, kc)) = sr_[i].ks1; } while (0)
#define AT_SWAIT() asm volatile("s_waitcnt vmcnt(0)" ::: "memory")
#define AT_RESC(a) do { if (__any((a) < 1.f)) { if (hi == 0) al_l[r32] = (a); asm volatile("s_waitcnt lgkmcnt(0)" ::: "memory"); \
    _Pragma("unroll") for (int d = 0; d < 4; ++d) _Pragma("unroll") for (int r = 0; r < 16; ++r) o[d][r] *= al_l[crow(r, hi)]; } } while (0)
  const unsigned* selr = MASKED ? sel + (size_t)(rb * QBLK + r32) * 64 : nullptr;
#define AT_MASK(P0, P1, t) do { if (MASKED) { const uint2 w_ = *reinterpret_cast<const uint2*>(selr + 2 * (t)); const unsigned w0 = w_.x >> (4 * hi), w1 = w_.y >> (4 * hi); \
    _Pragma("unroll") for (int r = 0; r < 16; ++r) { const unsigned bit = 1u << ((r & 3) + 8 * (r >> 2)); P0[r] = (w0 & bit) ? P0[r] : -INFINITY; P1[r] = (w1 & bit) ? P1[r] : -INFINITY; } } } while (0)
#define AT_ACT(t) ((t) <= tmax)
  f32x16 pA0, pA1, pB0, pB1; float mnA, mnB, alA = 1.f, alB = 1.f; bf16x8 pa0, pa1, pa2, pa3;
  constexpr int SE = 0, SO = 0;
  AT_SLOAD(SE, 0); asm volatile("s_waitcnt vmcnt(0)" ::: "memory"); AT_SWRITE(0, SE); __syncthreads();
  qkt(pA0, pA1, K_lds, qr, r32, hi); AT_MASK(pA0, pA1, 0); partialSM(pA0, pA1, m_reg, mnA, alA);
  AT_SLOAD(SO, KVBLK);
  AT_SWAIT(); AT_SWRITE(1, SO); __syncthreads();
  for (int j = 1; j + 1 < NT; j += 2) {
    AT_SBAR(); if (AT_ACT(j)) { qkt(pB0, pB1, K_lds + SHM_K, qr, r32, hi); AT_MASK(pB0, pB1, j); }
    if (AT_ACT(j - 1)) finishSM(pA0, pA1, alA, l_reg, pa0, pa1, pa2, pa3); AT_SBAR();
    AT_SLOAD(SO, (j + 1) * KVBLK); AT_SBAR();
    if (AT_ACT(j - 1)) pv_d0(o, vb0, pa0, pa1, pa2, pa3);
    if (AT_ACT(j)) partialSM(pB0, pB1, m_reg, mnB, alB);
    __syncthreads(); AT_SWAIT(); AT_SWRITE(0, SE);
    if (AT_ACT(j)) AT_RESC(alB);
    __syncthreads();
    AT_SBAR(); if (AT_ACT(j + 1)) { qkt(pA0, pA1, K_lds, qr, r32, hi); AT_MASK(pA0, pA1, j + 1); }
    if (AT_ACT(j)) finishSM(pB0, pB1, alB, l_reg, pa0, pa1, pa2, pa3); AT_SBAR();
    AT_SLOAD(SE, (j + 2) * KVBLK); AT_SBAR();
    if (AT_ACT(j)) pv_d0(o, vb0 + SHM_V, pa0, pa1, pa2, pa3);
    if (AT_ACT(j + 1)) partialSM(pA0, pA1, m_reg, mnA, alA);
    __syncthreads(); AT_SWAIT(); AT_SWRITE(1, SO);
    if (AT_ACT(j + 1)) AT_RESC(alA);
    __syncthreads();
  }
  AT_SBAR(); if (AT_ACT(NT - 1)) { qkt(pB0, pB1, K_lds + SHM_K, qr, r32, hi); AT_MASK(pB0, pB1, NT - 1); }
  if (AT_ACT(NT - 2)) { finishSM(pA0, pA1, alA, l_reg, pa0, pa1, pa2, pa3); AT_SBAR(); pv_d0(o, vb0, pa0, pa1, pa2, pa3); }
  if (AT_ACT(NT - 1)) { partialSM(pB0, pB1, m_reg, mnB, alB); AT_RESC(alB); finishSM(pB0, pB1, alB, l_reg, pa0, pa1, pa2, pa3); AT_SBAR(); pv_d0(o, vb0 + SHM_V, pa0, pa1, pa2, pa3); }
  if (hi == 0) li_l[r32] = l_reg; asm volatile("s_waitcnt lgkmcnt(0)" ::: "memory");
  float rli[16];
#pragma unroll
  for (int r = 0; r < 16; ++r) rli[r] = __builtin_amdgcn_rcpf(li_l[crow(r, hi)]);
#pragma unroll
  for (int r = 0; r < 16; ++r) { const int orow = rb * QBLK + crow(r, hi);
#pragma unroll
    for (int d0 = 0; d0 < 4; ++d0) { const float v = o[d0][r] * rli[r];
      if (OUTBF) { Ob[(size_t)orow * ldo + d0 * 32 + r32] = (bf16_t)(cvtpk(v, v) & 0xffffu); } else __hip_atomic_store(&Of[(size_t)orow * ldo + d0 * 32 + r32], v, __ATOMIC_RELAXED, __HIP_MEMORY_SCOPE_AGENT); } }
  if (!OUTBF) asm volatile("s_waitcnt vmcnt(0)" ::: "memory");
  __syncthreads();
#undef AT_SLOAD
#undef AT_SWRITE
#undef AT_SWAIT
#undef AT_RESC
#undef AT_MASK
#undef AT_ACT
}
#undef AT_KSWZ
#undef AT_SBAR
}
constexpr int NWAVES = 8;
constexpr int RING_OFF = 0, RING_BYTES = 131072;
constexpr int EPI_OFF = RING_BYTES;
constexpr int LDSCTL_OFF = EPI_OFF + 4096;
constexpr int LDS_BYTES = 147456;
constexpr int CW_WQ = 1024;
constexpr int CW_LQ = 2048;
constexpr int CW_CMB = 160000;
constexpr int CW_BAR = 4096;
constexpr int MAX_LAUNCHES = 40;
constexpr int NPH = 1 + 9 * DEPTH;


struct Frame {
    LAS unsigned char* lds; int tid, lane, wave, vcu, G;
    unsigned char* ws; const float* x; float* out;
};

__device__ __forceinline__ void frame_refresh(Frame& F) {
    int t = threadIdx.x; asm volatile("" : "+v"(t)); F.tid = t; F.lane = t & 63; F.wave = __builtin_amdgcn_readfirstlane(t >> 6);
}
__device__ __forceinline__ float wave_sum(float v) {
#pragma unroll
    for (int o = 1; o < 64; o <<= 1) v += __shfl_xor(v, o);
    return v;
}
__device__ __forceinline__ float wave_fmax(float f) {
    f = fmaxf(f, __int_as_float(__builtin_amdgcn_update_dpp(0, __float_as_int(f), 0xB1, 0xF, 0xF, true)));
    f = fmaxf(f, __int_as_float(__builtin_amdgcn_update_dpp(0, __float_as_int(f), 0x4E, 0xF, 0xF, true)));
    f = fmaxf(f, __int_as_float(__builtin_amdgcn_update_dpp(0, __float_as_int(f), 0x124, 0xF, 0xF, true)));
    f = fmaxf(f, __int_as_float(__builtin_amdgcn_update_dpp(0, __float_as_int(f), 0x128, 0xF, 0xF, true)));
    const int fi = __float_as_int(f);
    const float r0 = __int_as_float(__builtin_amdgcn_readlane(fi, 0)), r1 = __int_as_float(__builtin_amdgcn_readlane(fi, 16)), r2 = __int_as_float(__builtin_amdgcn_readlane(fi, 32)), r3 = __int_as_float(__builtin_amdgcn_readlane(fi, 48));
    return fmaxf(fmaxf(r0, r1), fmaxf(r2, r3));
}
__device__ __forceinline__ float wave_fsum_fast(float f) {
    f += __int_as_float(__builtin_amdgcn_update_dpp(0, __float_as_int(f), 0xB1, 0xF, 0xF, true));
    f += __int_as_float(__builtin_amdgcn_update_dpp(0, __float_as_int(f), 0x4E, 0xF, 0xF, true));
    f += __int_as_float(__builtin_amdgcn_update_dpp(0, __float_as_int(f), 0x124, 0xF, 0xF, true));
    f += __int_as_float(__builtin_amdgcn_update_dpp(0, __float_as_int(f), 0x128, 0xF, 0xF, true));
    const int fi = __float_as_int(f);
    return (__int_as_float(__builtin_amdgcn_readlane(fi, 0)) + __int_as_float(__builtin_amdgcn_readlane(fi, 16))) + (__int_as_float(__builtin_amdgcn_readlane(fi, 32)) + __int_as_float(__builtin_amdgcn_readlane(fi, 48)));
}
__device__ __forceinline__ int wave_isum_fast(int v) {
    v += __builtin_amdgcn_update_dpp(0, v, 0xB1, 0xF, 0xF, true);
    v += __builtin_amdgcn_update_dpp(0, v, 0x4E, 0xF, 0xF, true);
    v += __builtin_amdgcn_update_dpp(0, v, 0x124, 0xF, 0xF, true);
    v += __builtin_amdgcn_update_dpp(0, v, 0x128, 0xF, 0xF, true);
    return (__builtin_amdgcn_readlane(v, 0) + __builtin_amdgcn_readlane(v, 16)) + (__builtin_amdgcn_readlane(v, 32) + __builtin_amdgcn_readlane(v, 48));
}
__device__ __forceinline__ unsigned f2ord(float f) { const unsigned u = __float_as_uint(f); return u ^ ((u >> 31) ? 0xFFFFFFFFu : 0x80000000u); }
__device__ __forceinline__ float ord2f(unsigned o) { return __uint_as_float((o & 0x80000000u) ? (o ^ 0x80000000u) : ~o); }
__device__ __forceinline__ void p0_transpose_item(const float* W, int K, int N, int src, int cnt, bf16* WT, int dst_row0, int k0, LAS float* scr, int lane) {
    const int cl = lane & 31; const bool ok = cl < cnt;
#pragma unroll 8
    for (int i = 0; i < 32; ++i) { const int kk = 2 * i + (lane >> 5); scr[kk * 33 + cl] = ok ? W[(size_t)(k0 + kk) * N + src + cl] : 0.f; }
    LDS_WAIT(); asm volatile("" ::: "memory");
    const int c = lane & 7;
#pragma unroll
    for (int j = 0; j < 4; ++j) { const int n = (lane >> 3) + 8 * j; const LAS float* s = scr + (8 * c) * 33 + n;
        v4u o; o.x = pk2(s[0 * 33], s[1 * 33]); o.y = pk2(s[2 * 33], s[3 * 33]); o.z = pk2(s[4 * 33], s[5 * 33]); o.w = pk2(s[6 * 33], s[7 * 33]);
        *(GAS v4u*)(WT + (size_t)(dst_row0 + n) * K + k0 + 8 * c) = o; }
    LDS_WAIT(); asm volatile("" ::: "memory");
}

__device__ __forceinline__ void p0_prologue(Frame& F, const float* const (&in)[17]) {
    LAS float* scr = (LAS float*)(F.lds + RING_OFF + F.wave * 16384);
    const int gw = F.vcu * NWAVES + F.wave, NGW = F.G * NWAVES;
    {
        LAS float* ca = (LAS float*)(F.lds + RING_OFF);
        LAS float* red = (LAS float*)(F.lds + RING_OFF + 32768);
        const float* c = in[I_C];
        for (int i = F.tid; i < BATCH * DM; i += NWAVES * 64) { const float v = c[i]; ca[i] = v / (1.f + __expf(-v)); }
        __syncthreads();
        float* MOD = (float*)(F.ws + WS_MOD);
        for (int u = blockIdx.x; u < DEPTH * 64; u += F.G) {
            const int l = u >> 6, col0 = (u & 63) * 192;
            const float* w = in[I_WMOD] + (size_t)l * DM * 6 * DM + col0 + 4 * F.lane;
            f32x4 a0 = {0, 0, 0, 0}, a1 = a0, a2 = a0, a3 = a0;
            if (F.lane < 48) {
                const int d0 = F.wave * 256;
#pragma unroll 8
                for (int d = d0; d < d0 + 256; ++d) { const f32x4 wv = *(const GAS f32x4*)(w + (size_t)d * 6 * DM); a0 += wv * ca[d]; a1 += wv * ca[DM + d]; a2 += wv * ca[2 * DM + d]; a3 += wv * ca[3 * DM + d]; }
                LAS f32x4* r = (LAS f32x4*)(red + F.wave * 768) + F.lane;
                r[0] = a0; r[48] = a1; r[96] = a2; r[144] = a3;
            }
            __syncthreads();
            for (int i = F.tid; i < 768; i += NWAVES * 64) { float s = 0.f;
#pragma unroll
                for (int wv = 0; wv < 8; ++wv) s += red[wv * 768 + i];
                const int b = i / 192, cc = i % 192; MOD[((size_t)l * BATCH + b) * 6 * DM + col0 + cc] = s + in[I_BMOD][(size_t)l * 6 * DM + col0 + cc]; }
            __syncthreads();
        }
    }
    {
        float* r128 = (float*)(F.ws + WS_ROPE); float* r64 = r128 + SEQ * 64 * 2;
        const int gt = blockIdx.x * (NWAVES * 64) + F.tid, NT = F.G * NWAVES * 64;
        for (int i = gt; i < SEQ * 96; i += NT) {
            const int pos = i / 96, j = i % 96; const bool big = j < 64; const int ii = big ? j : j - 64;
            const float inv = 1.0f / powf(ROPE_THETA, (float)(2 * ii) / (big ? 128.f : 64.f)); const float ang = (float)pos * inv;
            float* o = big ? r128 + ((size_t)pos * 64 + ii) * 2 : r64 + ((size_t)pos * 32 + ii) * 2; o[0] = cosf(ang); o[1] = sinf(ang);
        }
        if (blockIdx.x == 1) {
            float* G = (float*)(F.ws + WS_GAINS);
            for (int i = F.tid; i < DEPTH * 1024; i += NWAVES * 64) { const int l = i >> 10, j = i & 1023;
                G[i] = j < 128 ? in[I_AQN][l * 128 + j] : j < 256 ? in[I_AKN][l * 128 + j - 128] : j < 384 ? in[I_CQN][l * 128 + j - 256] : j < 512 ? in[I_CKN][l * 128 + j - 384] : in[I_BVN][l * 512 + j - 512]; }
        }
        if (blockIdx.x == 2) {
            float* A = (float*)(F.ws + WS_SMALL);
            for (int i = F.tid; i < DEPTH * 256; i += NWAVES * 64) A[i] = in[I_ASUB][i];
            for (int i = F.tid; i < DEPTH * 512; i += NWAVES * 64) A[DEPTH * 256 + i] = in[I_BBIAS][i];
        }
        { bf16* WSB = (bf16*)(F.ws + WS_BWSB); const int gt2 = blockIdx.x * (NWAVES * 64) + F.tid;
          for (int i = gt2; i < DEPTH * 4 * 16384; i += F.G * NWAVES * 64) WSB[i] = (bf16)f2bf(in[I_BWS][i]); }
        if (blockIdx.x == 0 && F.wave < DEPTH) {
            const int l = F.wave; const float* lp = in[I_ALAM] + l * 512;
            const float s1 = wave_sum(lp[F.lane] * lp[128 + F.lane] + lp[64 + F.lane] * lp[192 + F.lane]);
            const float s2 = wave_sum(lp[256 + F.lane] * lp[384 + F.lane] + lp[320 + F.lane] * lp[448 + F.lane]);
            const float li = 0.8f - 0.6f * expf(-0.3f * (float)l);
            if (F.lane == 0) { float* L = (float*)(F.ws + WS_LAM); L[l] = expf(s1) - expf(s2) + li; L[DEPTH + l] = li; }
        }
    }
    {
        constexpr int I_IN = (DM / 64) * (NINP / 32), I_OUT = (DM / 64) * (DM / 32), I_F1 = (DM / 64) * (DFF / 32), I_F2 = (DFF / 64) * (DM / 32), I_L = I_IN + I_OUT + I_F1 + I_F2;
        for (int it = gw; it < DEPTH * I_L; it += NGW) {
            const int l = it / I_L; int r = it % I_L;
            if (r < I_IN) { const int kb = r / (NINP / 32), p32 = r % (NINP / 32); int src, cnt; pg8::in_src_block(p32, src, cnt);
                p0_transpose_item(in[I_WIN] + (size_t)l * DM * NIN, DM, NIN, src, cnt, (bf16*)(F.ws + WS_WIN) + (size_t)l * NINP * DM, p32 * 32, kb * 64, scr, F.lane); continue; } r -= I_IN;
            if (r < I_OUT) { const int kb = r / (DM / 32), nb = r % (DM / 32);
                p0_transpose_item(in[I_WOUT] + (size_t)l * DM * DM, DM, DM, nb * 32, 32, (bf16*)(F.ws + WS_WOUT) + (size_t)l * DM * DM, nb * 32, kb * 64, scr, F.lane); continue; } r -= I_OUT;
            if (r < I_F1) { const int kb = r / (DFF / 32), nb = r % (DFF / 32);
                p0_transpose_item(in[I_WFF1] + (size_t)l * DM * DFF, DM, DFF, nb * 32, 32, (bf16*)(F.ws + WS_WFF1) + (size_t)l * DM * DFF, nb * 32, kb * 64, scr, F.lane); continue; } r -= I_F1;
            { const int kb = r / (DM / 32), nb = r % (DM / 32);
                p0_transpose_item(in[I_WFF2] + (size_t)l * DM * DFF, DFF, DM, nb * 32, 32, (bf16*)(F.ws + WS_WFF2) + (size_t)l * DM * DFF, nb * 32, kb * 64, scr, F.lane); }
        }
    }
}

__device__ __forceinline__ void norm_phase(Frame& F, const float* X, const float* modl, int shi, int sci) {
    const int gw = F.vcu * NWAVES + F.wave, NGW = F.G * NWAVES; bf16* XN = (bf16*)(F.ws + WS_XN);
    for (int m = gw; m < M; m += NGW) {
        const GAS f32x4* xr = (const GAS f32x4*)(X + (size_t)m * DM) + F.lane;
        const float* mb = modl + (size_t)(m / SEQ) * 6 * DM;
        const GAS f32x4* sc = (const GAS f32x4*)(mb + sci * DM) + F.lane; const GAS f32x4* sh = (const GAS f32x4*)(mb + shi * DM) + F.lane;
        f32x4 v[8]; float s = 0.f;
#pragma unroll
        for (int j = 0; j < 8; ++j) { v[j] = xr[64 * j]; s += (v[j].x * v[j].x + v[j].y * v[j].y) + (v[j].z * v[j].z + v[j].w * v[j].w); }
        const float r = rsqrtf(wave_sum(s) * (1.f / DM) + EPS);
        GAS unsigned long long* o8 = (GAS unsigned long long*)(XN + (size_t)m * DM) + F.lane;
#pragma unroll
        for (int j = 0; j < 8; ++j) { const f32x4 a = sc[64 * j], b = sh[64 * j]; const f32x4 y = v[j] * r * (a + 1.f) + b;
            o8[64 * j] = (unsigned long long)pk2(y.x, y.y) | ((unsigned long long)pk2(y.z, y.w) << 32); }
    }
}
__device__ __forceinline__ void combine_phase(Frame& F, int l) {
    const int gw = F.vcu * NWAVES + F.wave, NGW = F.G * NWAVES; bf16* MIX = (bf16*)(F.ws + WS_MIX); const float* OA = (const float*)(F.ws + WS_OA);
    const float* L = (const float*)(F.ws + WS_LAM); const float lam = L[l], omli = 1.f - L[DEPTH + l];
    const f32x4 g = *((const GAS f32x4*)((const float*)(F.ws + WS_SMALL) + l * 256) + F.lane);
    for (int it = gw; it < M * 4; it += NGW) {
        const GAS f32x4* p = (const GAS f32x4*)(OA + (size_t)it * 512) + F.lane;
        const f32x4 o = p[0] - p[64] * lam;
        const float ss = wave_sum((o.x * o.x + o.y * o.y) + (o.z * o.z + o.w * o.w));
        const float r = rsqrtf(ss * (1.f / 256.f) + EPS) * omli;
        const f32x4 y = o * r * g; const int m = it >> 2, h = it & 3;
        *((GAS unsigned long long*)(MIX + (size_t)m * DM + h * 256) + F.lane) = (unsigned long long)pk2(y.x, y.y) | ((unsigned long long)pk2(y.z, y.w) << 32);
    }
}

__device__ __forceinline__ void combine_block(Frame& F, int l, int b, int h, int qb) {
    int t_ = threadIdx.x; asm volatile("" : "+v"(t_));
    const int lane = t_ & 63, wave = __builtin_amdgcn_readfirstlane(t_ >> 6);
    bf16* MIX = (bf16*)(F.ws + WS_MIX); const float* OA = (const float*)(F.ws + WS_OA);
    const float* L = (const float*)(F.ws + WS_LAM); const float lam = L[l], omli = 1.f - L[DEPTH + l];
    const f32x4 g = *((const GAS f32x4*)((const float*)(F.ws + WS_SMALL) + l * 256) + lane);
    const size_t m0 = (size_t)b * SEQ + 256 * qb + 32 * wave;
#pragma unroll 1
    for (int r = 0; r < 32; ++r) {
        const size_t mrow = m0 + r;
        const GAS f32x4* p = (const GAS f32x4*)(OA + (mrow * 4 + h) * 512) + lane;
        const f32x4 o = p[0] - p[64] * lam;
        const float ss = wave_fsum_fast((o.x * o.x + o.y * o.y) + (o.z * o.z + o.w * o.w));
        const float rr = rsqrtf(ss * (1.f / 256.f) + EPS) * omli;
        const f32x4 y = o * rr * g;
        *((GAS unsigned long long*)(MIX + mrow * DM + h * 256) + lane) = (unsigned long long)pk2(y.x, y.y) | ((unsigned long long)pk2(y.z, y.w) << 32);
    }
}
__device__ __forceinline__ int wave_isum(int v) {
#pragma unroll
    for (int o = 1; o < 64; o <<= 1) v += __shfl_xor(v, o);
    return v;
}
#ifndef IDXREP
#define IDXREP 0
#endif
template <int PART> __device__ __forceinline__ void index_unit(Frame& F, int u) {
    typedef short bf16x8s __attribute__((ext_vector_type(8)));
    const int b = u >> 7, q0 = (u & 127) * 16, nadm = ((q0 >> 6) + 1) * 64, ntile = nadm >> 4;
    const int lane = F.lane, n16 = lane & 15, kq = lane >> 4, wv = F.wave;
    unsigned* SEL = (unsigned*)(F.ws + WS_SEL) + (size_t)(b * SEQ + q0) * 64;
    const int nw = nadm >> 6;
    if (nadm <= TOPK) {
        if (PART & 2) for (int rr = 0; rr < 2; ++rr) { unsigned long long* out = (unsigned long long*)(SEL + (size_t)(wv * 2 + rr) * 64); if (lane < nw) out[lane] = ~0ull; }
        return;
    }
    LAS float* S = (LAS float*)(F.lds + RING_OFF);
    if (PART & 1) {
    const bf16* IQ = (const bf16*)(F.ws + WS_IQ) + (size_t)(b * SEQ + q0) * 512; const bf16* IK = (const bf16*)(F.ws + WS_IK) + (size_t)(b * SEQ) * 64;
    const float* IW = (const float*)(F.ws + WS_IW) + (size_t)(b * SEQ + q0) * 8;
    bf16x8s qa[8][2];
#pragma unroll
    for (int ih = 0; ih < 8; ++ih)
#pragma unroll
        for (int kk = 0; kk < 2; ++kk) qa[ih][kk] = *(const bf16x8s*)(IQ + (size_t)n16 * 512 + ih * 64 + kk * 32 + kq * 8);
    float w[4][8];
#pragma unroll
    for (int j = 0; j < 4; ++j) { const f32x4 a = *(const f32x4*)(IW + (4 * kq + j) * 8), c = *(const f32x4*)(IW + (4 * kq + j) * 8 + 4);
        w[j][0] = a.x; w[j][1] = a.y; w[j][2] = a.z; w[j][3] = a.w; w[j][4] = c.x; w[j][5] = c.y; w[j][6] = c.z; w[j][7] = c.w; }
    const bf16* kbase = IK + (size_t)n16 * 64 + kq * 8;
    bf16x8s kA[4][2], kB[4][2];
#define IDX_LOADG(dst, jb) do { _Pragma("unroll") for (int g_ = 0; g_ < 4; ++g_) { const int tt_ = wv + 8 * ((jb) + g_); if (tt_ < ntile) { const bf16* kr_ = kbase + (size_t)tt_ * 1024; dst[g_][0] = *(const bf16x8s*)kr_; dst[g_][1] = *(const bf16x8s*)(kr_ + 32); } } } while (0)
#define IDX_COMPG(src, jb) do { _Pragma("unroll") for (int g_ = 0; g_ < 4; ++g_) { const int tt_ = wv + 8 * ((jb) + g_); if (tt_ < ntile) { f32x4 sc_ = {0.f, 0.f, 0.f, 0.f}; \
        _Pragma("unroll") for (int ih = 0; ih < 8; ++ih) { f32x4 a_ = {0.f, 0.f, 0.f, 0.f}; \
            a_ = __builtin_amdgcn_mfma_f32_16x16x32_bf16(qa[ih][0], src[g_][0], a_, 0, 0, 0); a_ = __builtin_amdgcn_mfma_f32_16x16x32_bf16(qa[ih][1], src[g_][1], a_, 0, 0, 0); \
            _Pragma("unroll") for (int j = 0; j < 4; ++j) sc_[j] += fmaxf(a_[j], 0.f) * w[j][ih]; } \
        _Pragma("unroll") for (int j = 0; j < 4; ++j) S[(4 * kq + j) * 2048 + 16 * tt_ + n16] = sc_[j]; } } } while (0)
    IDX_LOADG(kA, 0);
    for (int jb = 0; wv + 8 * jb < ntile; jb += 8) { IDX_LOADG(kB, jb + 4); IDX_COMPG(kA, jb); IDX_LOADG(kA, jb + 8); IDX_COMPG(kB, jb + 4); }
#undef IDX_LOADG
#undef IDX_COMPG
    LDS_WAIT(); __syncthreads();
    }
    if (PART & 2) {
    for (int rr = 0; rr < 2; ++rr) {
        const int row = wv * 2 + rr; const LAS float* Sr = S + row * 2048;
        float key[32]; float mx = -INFINITY, mn = INFINITY;
#pragma unroll
        for (int i = 0; i < 32; ++i) { if (i < nw) { key[i] = Sr[64 * i + lane]; mx = fmaxf(mx, key[i]); mn = fminf(mn, key[i]); } else key[i] = -INFINITY; }
        mx = wave_fmax(mx); mn = -wave_fmax(-mn);
#if defined(IDX_CHECK)
        { float a = mx, c = mn;
#pragma unroll
          for (int o = 1; o < 64; o <<= 1) { a = fmaxf(a, __shfl_xor(a, o)); c = fminf(c, __shfl_xor(c, o)); }
          if (a != mx || c != mn) F.out[0] = __builtin_nanf(""); }
#endif
#define IDX_COUNT(dst, OPC, thr) do { int c_ = 0; const float t_ = (thr); \
        _Pragma("unroll") for (int g_ = 0; g_ < 4; ++g_) { if (8 * g_ < nw) { _Pragma("unroll") for (int i_ = 8 * g_; i_ < 8 * g_ + 8; ++i_) \
            asm volatile(OPC " vcc, %1, %2\n\tv_addc_co_u32 %0, vcc, 0, %0, vcc" : "+v"(c_) : "v"(key[i_]), "v"(t_) : "vcc"); } } dst = wave_isum_fast(c_); } while (0)
        float lo = mn, hi = mx; int c, clo = nadm, chi;
        IDX_COUNT(c, "v_cmp_ge_f32", mx); chi = c;
        if (c >= TOPK) lo = mx;
        else {
            for (int it = 0; it < 80; ++it) {
                float mid = (it % 3 == 2) ? 0.5f * lo + 0.5f * hi : lo + (hi - lo) * ((float)(clo - TOPK) + 0.5f) * __builtin_amdgcn_rcpf((float)(clo - chi));
                if (it >= 18 || !(mid > lo && mid < hi)) {
                    const unsigned lu = f2ord(lo), hu = f2ord(hi);
                    if (hu - lu <= 1u) break;
                    mid = ord2f(lu + ((hu - lu) >> 1));
                }
                IDX_COUNT(c, "v_cmp_ge_f32", mid);
                if (c >= TOPK) { lo = mid; clo = c; if (c == TOPK) break; } else { hi = mid; chi = c; }
            }
        }
        const float T = lo;
        int ngt; IDX_COUNT(ngt, "v_cmp_gt_f32", T);
        int need = TOPK - ngt;
#undef IDX_COUNT
        const unsigned long long lt = (1ull << lane) - 1ull;
        unsigned long long mine = 0ull;
#pragma unroll
        for (int i = 0; i < 32; ++i) {
            if (i < nw) {
                unsigned long long m = __ballot(key[i] > T);
                if (need > 0) { const unsigned long long eq = __ballot(key[i] == T);
                    if (eq != 0ull) { const int pre = __popcll(eq & lt); const bool tk = ((eq >> lane) & 1ull) && pre < need; const unsigned long long take = __ballot(tk); need -= __popcll(take); m |= take; } }
                if (lane == i) mine = m;
            }
        }
        if (lane < nw) ((unsigned long long*)(SEL + (size_t)row * 64))[lane] = mine;
    }
    __syncthreads();
    }
}
__device__ __forceinline__ void gmlp_unit(Frame& F, int u, int l) {
    typedef short bf16x8s __attribute__((ext_vector_type(8)));
    const int blk = u >> 2, g = u & 3, lane = F.lane, n16 = lane & 15, kq = lane >> 4, wv = F.wave;
    const size_t row0 = (size_t)blk * 128;
    const bf16* BV = (const bf16*)(F.ws + WS_BV) + row0 * 512 + g * 128; const bf16* BU = (const bf16*)(F.ws + WS_BU) + row0 * 512 + g * 128;
    bf16* MIX = (bf16*)(F.ws + WS_MIX) + row0 * DM + 1024 + g * 128;
    const bf16* Wg = (const bf16*)(F.ws + WS_BWSB) + ((size_t)l * 4 + g) * 16384; const float* bias = (const float*)(F.ws + WS_SMALL) + DEPTH * 256 + (size_t)l * 512 + g * 128;
    LAS bf16* Vt = (LAS bf16*)(F.lds + RING_OFF);
    for (int i = F.tid; i < 128 * 16; i += NWAVES * 64) { const int j = i >> 4, c8 = (i & 15) * 8; const bf16x8s x = *(const bf16x8s*)(BV + (size_t)j * 512 + c8);
#pragma unroll
        for (int e = 0; e < 8; ++e) Vt[(c8 + e) * 136 + j] = (bf16)x[e]; }
    LDS_WAIT(); __syncthreads();
    const int i0 = 16 * wv, jmax = (wv < 4) ? 64 : 128;
    f32x4 acc[8];
#pragma unroll
    for (int ct = 0; ct < 8; ++ct) acc[ct] = (f32x4){0.f, 0.f, 0.f, 0.f};
    for (int k0 = 0; k0 < jmax; k0 += 32) {
        const bf16x8s a = *(const bf16x8s*)(Wg + (size_t)(i0 + n16) * 128 + k0 + kq * 8);
#pragma unroll
        for (int ct = 0; ct < 8; ++ct) { const bf16x8s bfr = *(const LAS bf16x8s*)(Vt + (ct * 16 + n16) * 136 + k0 + kq * 8);
            acc[ct] = __builtin_amdgcn_mfma_f32_16x16x32_bf16(a, bfr, acc[ct], 0, 0, 0); }
    }
#pragma unroll
    for (int ct = 0; ct < 8; ++ct)
#pragma unroll
        for (int j = 0; j < 4; ++j) { const int i = i0 + 4 * kq + j, c = ct * 16 + n16;
            const float z = acc[ct][j] + bias[i]; const float uu = __uint_as_float(((unsigned)BU[(size_t)i * 512 + c]) << 16);
            MIX[(size_t)i * DM + c] = (bf16)f2bf(uu * z); }
    __syncthreads();
}

struct Args { const float* in[17]; float* out; unsigned char* ws; int ph_lo, ph_hi, li, pad; };
__global__ void __launch_bounds__(NWAVES * 64, 2) mega_fwd(Args args) {
    extern __shared__ __attribute__((aligned(16))) unsigned char lds[];
    Frame F;
    F.lds = (LAS unsigned char*)lds; F.tid = threadIdx.x; F.lane = F.tid & 63; F.wave = __builtin_amdgcn_readfirstlane(F.tid >> 6);
    F.G = gridDim.x; { const int bx = blockIdx.x; F.vcu = (F.G % 8 == 0) ? (bx % 8) * (F.G / 8) + bx / 8 : bx; }
    F.ws = args.ws; F.out = args.out; F.x = args.in[I_X];
    volatile LAS unsigned* LCTL = (volatile LAS unsigned*)(F.lds + LDSCTL_OFF);
    for (int u = F.tid; u < 64; u += NWAVES * 64) LCTL[u] = 0u;
    __syncthreads();
#define ctl ((gu32*)(F.ws + WS_CTL))
    XcdBarrier bar = xcd_barrier_post((unsigned*)(ctl + CW_BAR) + args.li * XCD_BAR_WORDS, LCTL);
    const int lo = args.ph_lo, hi = args.ph_hi;
#ifndef PHMASK
#define PHMASK 0x3ff
#endif
#define EN(b) ((PHMASK >> (b)) & 1)
#define IN(k) (lo <= (k) && (k) < hi)
#define SEAM(k) do { if (IN(k) && IN((k) + 1)) xcd_barrier(bar); } while (0)

#ifndef REPMASK
#define REPMASK 0
#endif
#define REP(b) ((REPMASK >> (b)) & 1)
#define SITE(bit, id, B, R) do { if (EN(bit) && IN(id)) { frame_refresh(F); B; if (REP(bit)) { xcd_barrier(bar); frame_refresh(F); R; } } SEAM(id); } while (0)

#define BODY_PRO() p0_prologue(F, args.in)
    SITE(9, 0, BODY_PRO(), BODY_PRO());

    for (int l = 0; l < DEPTH; ++l) {
        const int pb = 1 + 9 * l;
        if (hi <= pb || lo >= pb + 9) continue;
#define modl ((const float*)(F.ws + WS_MOD) + (size_t)l * BATCH * 6 * DM)
#define Xin ((l == 0) ? F.x : (const float*)F.out)
#define DUMMY ((float*)(F.ws + WS_PROJ))
        SITE(0, pb + 0, norm_phase(F, Xin, modl, 0, 1), norm_phase(F, Xin, modl, 0, 1));
#define BODY_IN() do { \
            pg8::Gemm g{(const pg8::bf16_t*)(F.ws + WS_XN), (const pg8::bf16_t*)(F.ws + WS_WIN) + (size_t)l * NINP * DM, M, NINP, DM}; \
            pg8::InOrder S; S.init(F.G, (int)blockIdx.x); \
            pg8::EpiIn E{F.ws, l, F.lds}; \
            pg8::gemm_phase<pg8::EpiIn, pg8::InOrder, true, true>(F.lds + RING_OFF, g, S, E); } while (0)
        SITE(1, pb + 1, BODY_IN(), BODY_IN());
#define BODY_IDX() do { \
            for (int i = blockIdx.x; i < 256; i += F.G) { \
                index_unit<1>(F, i); if (IDXREP & 1) index_unit<1>(F, i); index_unit<2>(F, i); if (IDXREP & 2) index_unit<2>(F, i); \
                index_unit<1>(F, 511 - i); if (IDXREP & 1) index_unit<1>(F, 511 - i); index_unit<2>(F, 511 - i); if (IDXREP & 2) index_unit<2>(F, 511 - i); } \
            for (int i = blockIdx.x; i < 256; i += F.G) { gmlp_unit(F, i, l); if (IDXREP & 4) gmlp_unit(F, i, l); } } while (0)
        SITE(2, pb + 2, BODY_IDX(), BODY_IDX());
#define BODY_ATTN(WQ) do { \
            if (blockIdx.x < 32) {     \
                const int bx_ = blockIdx.x; \
                pg8::Gemm g{(const pg8::bf16_t*)(F.ws + WS_XN), (const pg8::bf16_t*)(F.ws + WS_WIN) + (size_t)l * NINP * DM, M, NINP, DM}; \
                pg8::OneUnit S{8 * (bx_ >> 3) + ((bx_ >> 2) & 1), bx_ & 3}; pg8::EpiIn E{F.ws, l, F.lds}; \
                pg8::gemm_phase<pg8::EpiIn, pg8::OneUnit, true, true>(F.lds + RING_OFF, g, S, E); \
                VM_WAIT(); __syncthreads(); \
                if (F.tid == 0) { __builtin_amdgcn_fence(__ATOMIC_RELEASE, "agent"); VM_WAIT(); __hip_atomic_fetch_add(ctl + CW_LQ + 64 * (WQ), 1u, RLX_AGENT); } \
                frame_refresh(F); } \
            for (;;) { \
                if (F.tid == 0) LCTL[4] = __hip_atomic_fetch_add(ctl + CW_WQ + 64 * (WQ), 1u, RLX_AGENT); \
                __syncthreads(); \
                const int idx = (int)LCTL[4]; \
                __syncthreads(); \
                if (idx >= 640) break; \
                const int qb = 7 - idx / 80, r = idx % 80; \
                if (qb < 2 && r < 64) {     \
                    if (F.tid == 0) { unsigned sp_ = 0; while (__hip_atomic_load(ctl + CW_LQ + 64 * (WQ), RLX_AGENT) < 32u) { __builtin_amdgcn_s_sleep(2); if (++sp_ > (1u << 22)) break; } \
                        __builtin_amdgcn_fence(__ATOMIC_ACQUIRE, "agent"); VM_WAIT(); } \
                    __syncthreads(); } \
                if (r < 64) { const int b = r >> 4, h = (r >> 2) & 3, mp = (r >> 1) & 1, vh = r & 1; const size_t rq = (size_t)b * SEQ + 256 * qb, rk = (size_t)b * SEQ; \
                    const bf16* AQ = (const bf16*)(F.ws + WS_AQ); const bf16* AK = (const bf16*)(F.ws + WS_AK); const bf16* AV = (const bf16*)(F.ws + WS_AV); float* OA = (float*)(F.ws + WS_OA); \
                    at::attn_unit<1024, 1024, false, false>(AQ + rq * 1024 + h * 256 + mp * 128, AK + rk * 1024 + h * 256 + mp * 128, AV + rk * 1024 + h * 256 + vh * 128, qb, nullptr, \
                                                            OA + rq * 2048 + h * 512 + mp * 256 + vh * 128, nullptr, 2048, (char*)lds + RING_OFF); \
                      \
                    if (F.tid == 0) { const unsigned old_ = __hip_atomic_fetch_add(ctl + CW_CMB + 64 * ((((WQ) * 4 + b) * 4 + h) * 8 + qb), 1u, RLX_AGENT); \
                        if (old_ == 3u) { __builtin_amdgcn_fence(__ATOMIC_ACQUIRE, "agent"); VM_WAIT(); } LCTL[5] = old_; } \
                    __syncthreads(); \
                    const bool last_ = (LCTL[5] == 3u); \
                    __syncthreads(); \
                    if (last_) { combine_block(F, l, b, h, qb); } } \
                else { const int b = (r - 64) >> 2, h = (r - 64) & 3; const size_t rq = (size_t)b * SEQ + 256 * qb, rk = (size_t)b * SEQ; \
                    const bf16* CQ = (const bf16*)(F.ws + WS_CQ); const bf16* CK = (const bf16*)(F.ws + WS_CK); const bf16* CV = (const bf16*)(F.ws + WS_CV); bf16* MIX = (bf16*)(F.ws + WS_MIX); const unsigned* SEL = (const unsigned*)(F.ws + WS_SEL); \
                    at::attn_unit<512, 512, true, true>(CQ + rq * 512 + h * 128, CK + rk * 512 + h * 128, CV + rk * 512 + h * 128, qb, SEL + rq * 64, \
                                                        nullptr, MIX + rq * DM + 1536 + h * 128, DM, (char*)lds + RING_OFF); } \
            } } while (0)
        SITE(3, pb + 3, BODY_ATTN(l), BODY_ATTN(l + DEPTH));
#define BODY_OUT(BASE, DST) do { \
            pg8::Gemm g{(const pg8::bf16_t*)(F.ws + WS_MIX), (const pg8::bf16_t*)(F.ws + WS_WOUT) + (size_t)l * DM * DM, M, DM, DM}; \
            pg8::StaticOrder S; S.init(M, DM, F.G, (int)blockIdx.x); \
            pg8::EpiRes E{BASE, DST, modl + 2 * DM}; \
            pg8::gemm_phase<pg8::EpiRes, pg8::StaticOrder, true, true>(F.lds + RING_OFF, g, S, E); } while (0)
        SITE(5, pb + 5, BODY_OUT(Xin, F.out), BODY_OUT(F.out, DUMMY));
        SITE(6, pb + 6, norm_phase(F, F.out, modl, 3, 4), norm_phase(F, F.out, modl, 3, 4));
#define BODY_FF1() do { \
            pg8::Gemm g{(const pg8::bf16_t*)(F.ws + WS_XN), (const pg8::bf16_t*)(F.ws + WS_WFF1) + (size_t)l * DM * DFF, M, DFF, DM}; \
            pg8::StaticOrder S; S.init(M, DFF, F.G, (int)blockIdx.x); \
            pg8::EpiRelu2 E{(bf16*)(F.ws + WS_FF), DFF}; \
            pg8::gemm_phase<pg8::EpiRelu2, pg8::StaticOrder, true, true>(F.lds + RING_OFF, g, S, E); } while (0)
        SITE(7, pb + 7, BODY_FF1(), BODY_FF1());
#define BODY_FF2(DST) do { \
            pg8::Gemm g{(const pg8::bf16_t*)(F.ws + WS_FF), (const pg8::bf16_t*)(F.ws + WS_WFF2) + (size_t)l * DM * DFF, M, DM, DFF}; \
            pg8::StaticOrder S; S.init(M, DM, F.G, (int)blockIdx.x); \
            pg8::EpiRes E{F.out, DST, modl + 5 * DM}; \
            pg8::gemm_phase<pg8::EpiRes, pg8::StaticOrder, true, true>(F.lds + RING_OFF, g, S, E); } while (0)
        SITE(8, pb + 8, BODY_FF2(F.out), BODY_FF2(DUMMY));
    }
#undef modl
#undef Xin
#undef DUMMY
#undef ctl
#undef IN
#undef SEAM
}

static int mega_grid = 0;
static bool mega_setup() {
    if (mega_grid == 0) {
        int dev = 0, cus = 0, per_cu = 0;
        if (hipGetDevice(&dev) != hipSuccess || hipDeviceGetAttribute(&cus, hipDeviceAttributeMultiprocessorCount, dev) != hipSuccess) { fprintf(stderr, "mega: device query failed\n"); mega_grid = -1; return false; }
        if (hipFuncSetAttribute((const void*)mega_fwd, hipFuncAttributeMaxDynamicSharedMemorySize, LDS_BYTES) != hipSuccess) { fprintf(stderr, "mega: hipFuncSetAttribute failed\n"); mega_grid = -1; return false; }
        if (hipOccupancyMaxActiveBlocksPerMultiprocessor(&per_cu, (const void*)mega_fwd, NWAVES * 64, LDS_BYTES) != hipSuccess || per_cu < 1) fprintf(stderr, "mega: occupancy query says %d\n", per_cu);
        (void)hipGetLastError();
        mega_grid = cus;
    }
    return mega_grid > 0;
}
static void mega_launch(void* const* d_in, void* d_out, void* d_ws, hipStream_t stream, int ph_lo, int ph_hi, int li) {
    if (!mega_setup()) return;
    Args a{};
    for (int i = 0; i < 17; ++i) a.in[i] = (const float*)d_in[i];
    a.out = (float*)d_out; a.ws = (unsigned char*)d_ws; a.ph_lo = ph_lo; a.ph_hi = ph_hi; a.li = li; a.pad = 0;
    hipLaunchKernelGGL(mega_fwd, dim3(mega_grid), dim3(NWAVES * 64), LDS_BYTES, stream, a);
    const hipError_t le = hipPeekAtLastError();
    if (le != hipSuccess) fprintf(stderr, "mega: launch failed: %s\n", hipGetErrorName(le));
}
extern "C" void kernel_launch(void* const* d_in, const int* in_sizes, int n_in, void* d_out, int out_size, void* d_ws, size_t ws_size, hipStream_t stream) {
    if (n_in != 17 || out_size != M * DM || ws_size < WS_END) { fprintf(stderr, "kernel_launch: unexpected shapes n_in %d out %d ws %zu (need %zu)\n", n_in, out_size, ws_size, (size_t)WS_END); return; }
    (void)hipMemsetAsync((char*)d_ws + WS_CTL, 0, CTL_ZERO_BYTES, stream);
    mega_launch(d_in, d_out, d_ws, stream, 0, NPH, 0);
}
```
